# Optimizing an MI355X kernel written in HIP

```python
import jax
import jax.numpy as jnp
from jax import lax
import numpy as np

D_MODEL = 1024
BATCH = 4
SEQ = 4096
DEPTH = 4
DEC_BATCH = 128
DEC_SEQ = 1
PAST_LEN = 8192
PAGE_SIZE = 128

HEAD_DIM = 64
MIX_W = D_MODEL
MEM_HEADS = 4
MEM_W = MEM_HEADS * HEAD_DIM
N_MEM = 256
D_RNN = MIX_W - MEM_W
RNN_BLOCKS = D_RNN // HEAD_DIM
RNN_BLOCK = D_RNN // RNN_BLOCKS
CONV_A = 4
LRU_C = 8.0
N_Q = (MIX_W - MEM_W) // HEAD_DIM
N_KV = 4
GROUP = N_Q // N_KV
Q_W = N_Q * HEAD_DIM
KV_W = N_KV * HEAD_DIM
WINDOW = 128
ROPE_THETA = 10000.0
D_FF = 3 * D_MODEL
CONV_F = 3
N_A = DEPTH // 2
N_B = DEPTH - N_A
EPS = 1e-6
NEG = -1e30
ATT_SCALE = HEAD_DIM ** -0.5

kernel_name = 'yoco_hawk_swa_sink_convffn_decoder'


def _rmsnorm(x, g):
    x32 = x.astype(jnp.float32)
    r = lax.rsqrt(jnp.mean(x32 * x32, axis=-1, keepdims=True) + EPS)
    return (x32 * r * g.astype(jnp.float32)).astype(x.dtype)


def _rope(x, pos):
    half = HEAD_DIM // 2
    inv = ROPE_THETA ** (-jnp.arange(half, dtype=jnp.float32) / half)
    ang = pos.astype(jnp.float32)[:, None] * inv[None, :]
    cos = jnp.cos(ang)[:, None, :]
    sin = jnp.sin(ang)[:, None, :]
    x32 = x.astype(jnp.float32)
    x1, x2 = x32[..., :half], x32[..., half:]
    return jnp.concatenate([x1 * cos - x2 * sin, x2 * cos + x1 * sin], axis=-1).astype(x.dtype)


def _causal_dwconv(x, buf, w, b):
    k = w.shape[0]
    s = x.shape[1]
    xp = jnp.concatenate([buf.astype(x.dtype), x], axis=1)
    out = xp[:, 0:s] * w[0]
    for j in range(1, k):
        out = out + xp[:, j:j + s] * w[j]
    return out + b, xp[:, s:]


def _rglru(x, h0, w_gx, b_gx, w_ga, b_ga, lru_param):
    bsz, s, _ = x.shape
    x32 = x.astype(jnp.float32)
    xb = x32.reshape(bsz, s, RNN_BLOCKS, RNN_BLOCK)
    gx = jax.nn.sigmoid(jnp.einsum('bsnk,nkj->bsnj', xb, w_gx.astype(jnp.float32)).reshape(bsz, s, D_RNN) + b_gx.astype(jnp.float32))
    ga = jax.nn.sigmoid(jnp.einsum('bsnk,nkj->bsnj', xb, w_ga.astype(jnp.float32)).reshape(bsz, s, D_RNN) + b_ga.astype(jnp.float32))
    log_a = LRU_C * ga * jax.nn.log_sigmoid(lru_param.astype(jnp.float32))
    a = jnp.exp(log_a)
    bx = jnp.sqrt(-jnp.expm1(2.0 * log_a)) * gx * x32
    bx = bx.at[:, 0].add(a[:, 0] * h0.astype(jnp.float32))

    def comb(c1, c2):
        a1, b1 = c1
        a2, b2 = c2
        return a1 * a2, a2 * b1 + b2

    _, h = lax.associative_scan(comb, (a, bx), axis=1)
    return h.astype(x.dtype), h[:, -1].astype(x.dtype)


def _attend_sink(q, k, v, mask, sink):
    s = jnp.einsum('...tkgd,...lkd->...kgtl', q.astype(jnp.float32), k.astype(jnp.float32)) * ATT_SCALE
    s = jnp.where(mask, s, NEG)
    sk = sink.astype(jnp.float32)[..., None, None]
    m = jnp.maximum(jnp.max(s, axis=-1, keepdims=True), sk)
    p = jnp.exp(s - m)
    den = jnp.sum(p, axis=-1, keepdims=True) + jnp.exp(sk - m)
    o = jnp.einsum('...kgtl,...lkd->...tkgd', p / den, v.astype(jnp.float32))
    return o.astype(q.dtype)


def _swa_prompt(q, k, v, sink):
    bsz, s = q.shape[0], q.shape[1]
    nb = s // WINDOW
    qb = q.reshape(bsz, nb, WINDOW, N_KV, GROUP, HEAD_DIM)
    kb = k.reshape(bsz, nb, WINDOW, N_KV, HEAD_DIM)
    vb = v.reshape(bsz, nb, WINDOW, N_KV, HEAD_DIM)
    kk = jnp.concatenate([jnp.concatenate([jnp.zeros_like(kb[:, :1]), kb[:, :-1]], axis=1), kb], axis=2)
    vv = jnp.concatenate([jnp.concatenate([jnp.zeros_like(vb[:, :1]), vb[:, :-1]], axis=1), vb], axis=2)
    qi = jnp.arange(WINDOW)[:, None]
    kj = jnp.arange(2 * WINDOW)[None, :] - WINDOW
    band = (kj <= qi) & (kj >= qi - WINDOW)
    valid = (jnp.arange(nb)[:, None, None] > 0) | (kj >= 0)[None]
    mask = (band[None] & valid)[:, None, None]
    o = _attend_sink(qb, kk, vv, mask, sink.reshape(N_KV, GROUP))
    return o.reshape(bsz, s, Q_W)


def _swa_sample(q, kbuf, vbuf, knew, vnew, sink):
    dbsz, t = q.shape[0], q.shape[1]
    wb = kbuf.shape[1]
    k = jnp.concatenate([kbuf.astype(knew.dtype), knew], axis=1)
    v = jnp.concatenate([vbuf.astype(vnew.dtype), vnew], axis=1)
    qpos = PAST_LEN + jnp.arange(t, dtype=jnp.int32)
    kpos = jnp.concatenate([PAST_LEN - wb + jnp.arange(wb, dtype=jnp.int32), qpos])
    mask = (kpos[None, :] <= qpos[:, None]) & (kpos[None, :] >= qpos[:, None] - WINDOW)
    o = _attend_sink(q.reshape(dbsz, t, N_KV, GROUP, HEAD_DIM), k, v, mask, sink.reshape(N_KV, GROUP))
    return o.reshape(dbsz, t, Q_W)


def _mem_attn(q, k, v):
    s = jnp.einsum('bthd,bmhd->bhtm', q.astype(jnp.float32), k.astype(jnp.float32)) * ATT_SCALE
    p = jax.nn.softmax(s, axis=-1)
    o = jnp.einsum('bhtm,bmhd->bthd', p, v.astype(jnp.float32))
    return o.reshape(o.shape[0], o.shape[1], MEM_W).astype(q.dtype)


def _mem_kv(mem, g, w, kg):
    bsz = mem.shape[0]
    h = _rmsnorm(mem, g) @ w
    k = _rmsnorm(h[..., :MEM_W].reshape(bsz, N_MEM, MEM_HEADS, HEAD_DIM), kg)
    v = h[..., MEM_W:].reshape(bsz, N_MEM, MEM_HEADS, HEAD_DIM)
    return k, v


def _shared_kv(x, pos, g, w, kg):
    bsz, s = x.shape[0], x.shape[1]
    h = _rmsnorm(x, g) @ w
    k = _rope(_rmsnorm(h[..., :KV_W].reshape(bsz, s, N_KV, HEAD_DIM), kg), pos)
    v = h[..., KV_W:].reshape(bsz, s, N_KV, HEAD_DIM)
    return k, v


def _conv_ffn(x, buf, w_up, cw, cb, w_down):
    u = x @ w_up
    u, nbuf = _causal_dwconv(u, buf, cw, cb)
    return (jax.nn.gelu(u[..., :D_FF]) * u[..., D_FF:]) @ w_down, nbuf


def _trunk(x, pos, rnn_h0, rnn_conv0, ffn_conv0, mem_k, mem_v, kv_past, prm):
    bsz, s = x.shape[0], x.shape[1]
    hs, rcs, fcs = [], [], []
    k_sh = None
    v_sh = None
    for l in range(DEPTH):
        hn = _rmsnorm(x, prm['norm_mix_g'][l])
        if l < N_A:
            u = hn @ prm['w_in_a'][l]
            gate, xr, qm = u[..., :D_RNN], u[..., D_RNN:2 * D_RNN], u[..., 2 * D_RNN:]
            xr, rc = _causal_dwconv(xr, rnn_conv0[l], prm['rnn_conv_w'][l], prm['rnn_conv_b'][l])
            y, hl = _rglru(xr, rnn_h0[l], prm['w_gate_x'][l], prm['b_gate_x'][l], prm['w_gate_a'][l], prm['b_gate_a'][l], prm['lru_param'][l])
            main = y * jax.nn.gelu(gate)
            hs.append(hl)
            rcs.append(rc)
        else:
            j = l - N_A
            u = hn @ prm['w_in_b'][j]
            q, qm = u[..., :Q_W], u[..., Q_W:]
            q = _rope(_rmsnorm(q.reshape(bsz, s, N_Q, HEAD_DIM), prm['q_norm_g'][j]), pos)
            if kv_past is None:
                main = _swa_prompt(q, k_sh, v_sh, prm['sinks'][j])
            else:
                main = _swa_sample(q, kv_past[0], kv_past[1], k_sh, v_sh, prm['sinks'][j])
        qm = _rmsnorm(qm.reshape(bsz, s, MEM_HEADS, HEAD_DIM), prm['mem_q_norm_g'][l])
        mo = _mem_attn(qm, mem_k[l], mem_v[l])
        x = x + jnp.concatenate([main, mo], axis=-1) @ prm['w_out'][l]
        hn = _rmsnorm(x, prm['norm_ffn_g'][l])
        f, fc = _conv_ffn(hn, ffn_conv0[l], prm['w_ffn_up'][l], prm['ffn_conv_w'][l], prm['ffn_conv_b'][l], prm['w_ffn_down'][l])
        x = x + f
        fcs.append(fc)
        if l == N_A - 1:
            k_sh, v_sh = _shared_kv(x, pos, prm['kv_norm_g'], prm['w_kv'], prm['k_norm_g'])
    if kv_past is None:
        keep = min(WINDOW, s)
        k_state, v_state = k_sh[:, s - keep:], v_sh[:, s - keep:]
    else:
        k_state, v_state = k_sh, v_sh
    return x, jnp.stack(hs), jnp.stack(rcs), jnp.stack(fcs), k_state, v_state


def setup_inputs(seed: int = 0) -> dict:
    key = jax.random.key(seed)
    ks = jax.random.split(key, 36)
    f32 = jnp.float32

    def nrm(i, shape, scale):
        return jax.random.normal(ks[i], shape, f32) * scale

    def gain(i, shape):
        return 1.0 + nrm(i, shape, 0.1)

    w_buf = min(WINDOW, PAST_LEN)
    lru_a = jax.random.uniform(ks[19], (N_A, D_RNN), f32, 0.9, 0.999)
    out_scale = MIX_W ** -0.5 * (2 * DEPTH) ** -0.5
    return {
        'x_prompt': nrm(0, (BATCH, SEQ, D_MODEL), 1.0),
        'x_sample': nrm(1, (DEC_BATCH, DEC_SEQ, D_MODEL), 1.0),
        'state_rglru_h': nrm(2, (N_A, DEC_BATCH, D_RNN), 0.5),
        'state_rglru_conv': nrm(3, (N_A, DEC_BATCH, CONV_A - 1, D_RNN), 0.5),
        'state_ffn_conv': nrm(4, (DEPTH, DEC_BATCH, CONV_F - 1, 2 * D_FF), 0.5),
        'cache_swa_k': nrm(5, (DEC_BATCH, w_buf, N_KV, HEAD_DIM), 1.0),
        'cache_swa_v': nrm(6, (DEC_BATCH, w_buf, N_KV, HEAD_DIM), 1.0),
        'cache_mem_k': nrm(7, (DEPTH, DEC_BATCH, N_MEM, MEM_HEADS, HEAD_DIM), 1.0),
        'cache_mem_v': nrm(8, (DEPTH, DEC_BATCH, N_MEM, MEM_HEADS, HEAD_DIM), 1.0),
        'mem_prompt': nrm(9, (BATCH, N_MEM, D_MODEL), 1.0),
        'norm_mix_g': gain(10, (DEPTH, D_MODEL)),
        'norm_ffn_g': gain(11, (DEPTH, D_MODEL)),
        'w_in_a': nrm(12, (N_A, D_MODEL, 2 * D_RNN + MEM_W), D_MODEL ** -0.5),
        'rnn_conv_w': nrm(13, (N_A, CONV_A, D_RNN), CONV_A ** -0.5),
        'rnn_conv_b': nrm(14, (N_A, D_RNN), 0.02),
        'w_gate_x': nrm(15, (N_A, RNN_BLOCKS, RNN_BLOCK, RNN_BLOCK), RNN_BLOCK ** -0.5),
        'b_gate_x': nrm(16, (N_A, D_RNN), 0.02),
        'w_gate_a': nrm(17, (N_A, RNN_BLOCKS, RNN_BLOCK, RNN_BLOCK), RNN_BLOCK ** -0.5),
        'b_gate_a': nrm(18, (N_A, D_RNN), 0.02),
        'lru_param': jnp.log(lru_a) - jnp.log1p(-lru_a),
        'w_in_b': nrm(20, (N_B, D_MODEL, Q_W + MEM_W), D_MODEL ** -0.5),
        'q_norm_g': gain(21, (N_B, HEAD_DIM)),
        'sinks': nrm(22, (N_B, N_Q), 0.5),
        'kv_norm_g': gain(23, (D_MODEL,)),
        'w_kv': nrm(24, (D_MODEL, 2 * KV_W), D_MODEL ** -0.5),
        'k_norm_g': gain(25, (HEAD_DIM,)),
        'mem_norm_g': gain(26, (DEPTH, D_MODEL)),
        'w_mem_kv': nrm(27, (DEPTH, D_MODEL, 2 * MEM_W), D_MODEL ** -0.5),
        'mem_q_norm_g': gain(28, (DEPTH, HEAD_DIM)),
        'mem_k_norm_g': gain(29, (DEPTH, HEAD_DIM)),
        'w_out': nrm(30, (DEPTH, MIX_W, D_MODEL), out_scale),
        'w_ffn_up': nrm(31, (DEPTH, D_MODEL, 2 * D_FF), D_MODEL ** -0.5),
        'ffn_conv_w': nrm(32, (DEPTH, CONV_F, 2 * D_FF), CONV_F ** -0.5),
        'ffn_conv_b': nrm(33, (DEPTH, 2 * D_FF), 0.02),
        'w_ffn_down': nrm(34, (DEPTH, D_FF, D_MODEL), D_FF ** -0.5 * (2 * DEPTH) ** -0.5),
    }


def reference(x_prompt, x_sample, state_rglru_h, state_rglru_conv, state_ffn_conv, cache_swa_k, cache_swa_v, cache_mem_k, cache_mem_v, mem_prompt, norm_mix_g, norm_ffn_g, w_in_a, rnn_conv_w, rnn_conv_b, w_gate_x, b_gate_x, w_gate_a, b_gate_a, lru_param, w_in_b, q_norm_g, sinks, kv_norm_g, w_kv, k_norm_g, mem_norm_g, w_mem_kv, mem_q_norm_g, mem_k_norm_g, w_out, w_ffn_up, ffn_conv_w, ffn_conv_b, w_ffn_down):
    prm = {
        'norm_mix_g': norm_mix_g, 'norm_ffn_g': norm_ffn_g, 'w_in_a': w_in_a,
        'rnn_conv_w': rnn_conv_w, 'rnn_conv_b': rnn_conv_b, 'w_gate_x': w_gate_x,
        'b_gate_x': b_gate_x, 'w_gate_a': w_gate_a, 'b_gate_a': b_gate_a,
        'lru_param': lru_param, 'w_in_b': w_in_b, 'q_norm_g': q_norm_g, 'sinks': sinks,
        'kv_norm_g': kv_norm_g, 'w_kv': w_kv, 'k_norm_g': k_norm_g,
        'mem_q_norm_g': mem_q_norm_g, 'w_out': w_out, 'w_ffn_up': w_ffn_up,
        'ffn_conv_w': ffn_conv_w, 'ffn_conv_b': ffn_conv_b, 'w_ffn_down': w_ffn_down,
    }
    mks, mvs = [], []
    for l in range(DEPTH):
        mk, mv = _mem_kv(mem_prompt, mem_norm_g[l], w_mem_kv[l], mem_k_norm_g[l])
        mks.append(mk)
        mvs.append(mv)
    p_mem_k = jnp.stack(mks)
    p_mem_v = jnp.stack(mvs)
    bsz, s = x_prompt.shape[0], x_prompt.shape[1]
    dt = x_prompt.dtype
    h0 = jnp.zeros((N_A, bsz, D_RNN), dt)
    rc0 = jnp.zeros((N_A, bsz, CONV_A - 1, D_RNN), dt)
    fc0 = jnp.zeros((DEPTH, bsz, CONV_F - 1, 2 * D_FF), dt)
    pos_p = jnp.arange(s, dtype=jnp.int32)
    y_prompt, p_h, p_rc, p_fc, p_k, p_v = _trunk(x_prompt, pos_p, h0, rc0, fc0, p_mem_k, p_mem_v, None, prm)
    pos_s = PAST_LEN + jnp.arange(x_sample.shape[1], dtype=jnp.int32)
    y_sample, s_h, s_rc, s_fc, s_k, s_v = _trunk(x_sample, pos_s, state_rglru_h, state_rglru_conv, state_ffn_conv, cache_mem_k, cache_mem_v, (cache_swa_k, cache_swa_v), prm)
    return (y_prompt, y_sample, p_h, p_rc, p_fc, p_k, p_v, p_mem_k, p_mem_v, s_h, s_rc, s_fc, s_k, s_v)
```

```cpp
#include <hip/hip_runtime.h>
#include <hip/hip_cooperative_groups.h>
#include <cstdio>
#include <cstdint>
namespace cg = cooperative_groups;

#ifndef MK_SPLIT
#define MK_SPLIT 0
#endif

#define LAS __attribute__((address_space(3)))
typedef unsigned short bf16_t;
typedef short bf16x8 __attribute__((ext_vector_type(8)));
typedef float f32x4 __attribute__((ext_vector_type(4)));
typedef float f32x2 __attribute__((ext_vector_type(2)));
typedef unsigned u32x4 __attribute__((ext_vector_type(4)));
typedef unsigned u32x2 __attribute__((ext_vector_type(2)));

namespace pg8 {
constexpr int BM = 256, BK = 64, HALF = 128, HTB = HALF * BK * 2, STAGE_BYTES = 8 * HTB, NXCD = 8, WGM = 8;
__host__ __device__ __forceinline__ int lds_byte(int r, int c) { const int st = (r >> 4) * 2 + (c >> 5), rr = r & 15, cc = c & 31, ob = rr * 64 + cc * 2; return st * 1024 + (ob ^ (((ob >> 9) & 1) << 5)); }
__host__ __device__ __forceinline__ void stage_rc(int b, int& R, int& C) { const int st = b / 1024, sb = b % 1024, swz = sb ^ (((sb >> 9) & 1) << 5); R = (st >> 1) * 16 + swz / 64; C = (st & 1) * 32 + (swz % 64) / 2; }
__host__ __device__ __forceinline__ int perm32(int rho) { const int n = rho >> 4, i = rho & 15; return 8 * (i >> 2) + 4 * n + (i & 3); }
struct Unit { int pm, pn; };
struct Gemm { const bf16_t* A; const bf16_t* Bt; int M, N, K; };
struct StaticOrder {
    int nM, nN, nwg, G, c;
    __host__ __device__ void init(int M, int N, int G_, int c_) { nM = M / BM; nN = N / BM; nwg = nM * nN; G = G_; c = c_; }
    __host__ __device__ bool next(int i, Unit& u) const {
        const long L = (long)i * G + c; if (L >= nwg) return false;
        int wgid = (int)L; { const int q = nwg / NXCD, r = nwg % NXCD, xcd = wgid % NXCD, off = wgid / NXCD; wgid = (xcd < r ? xcd * (q + 1) : r * (q + 1) + (xcd - r) * q) + off; }
        const int nig = WGM * nN, gid = wgid / nig, fm = gid * WGM, gsz = (nM - fm) < WGM ? (nM - fm) : WGM;
        u.pm = fm + ((wgid % nig) % gsz); u.pn = (wgid % nig) / gsz; return true;
    }
    __device__ __forceinline__ void a_ready(const Unit&) const {}
    __device__ __forceinline__ void done(const Unit&) const {}
};
__device__ __forceinline__ unsigned cvt_pk_bf16(float lo, float hi) { unsigned r; asm volatile("v_cvt_pk_bf16_f32 %0, %1, %2" : "=v"(r) : "v"(lo), "v"(hi)); return r; }

struct EpiScaleBf16 {
    static constexpr bool PERM = true, AFTER_DRAIN = false, APERM = false;
    bf16_t* O; int ldc; const float* ssq;
    __device__ __forceinline__ void operator()(const f32x4 (&acc)[2][2][4][2], const Unit& u, int wr, int wc, int fr, int fq) const {
        const unsigned row0 = (unsigned)(u.pm * BM + wr * 64 + fr), col0 = (unsigned)(u.pn * BM + wc * 32 + 8 * fq);
        f32x4 pp[2][4];
#pragma unroll
        for (int ai = 0; ai < 2; ++ai)
#pragma unroll
            for (int m = 0; m < 4; ++m) pp[ai][m] = *(const f32x4*)((const char*)ssq + ((row0 + ai * HALF + m * 16) * 16u + 4u * fq) * 4u);
#pragma unroll
        for (int ai = 0; ai < 2; ++ai)
#pragma unroll
            for (int m = 0; m < 4; ++m) {
                const unsigned row = row0 + ai * HALF + m * 16;
                const f32x4 p = pp[ai][m];
                float s = (p[0] + p[1]) + (p[2] + p[3]); s += __shfl_xor(s, 16); s += __shfl_xor(s, 32);
                const float r = __builtin_amdgcn_rsqf(s * (1.0f / 1024.0f) + 1e-6f);
                bf16_t* rowp = O + (size_t)row * ldc + col0;
#pragma unroll
                for (int bj = 0; bj < 2; ++bj) { const f32x4 v0 = acc[ai][bj][m][0] * r, v1 = acc[ai][bj][m][1] * r;
                    u32x4 w; w.x = cvt_pk_bf16(v0[0], v0[1]); w.y = cvt_pk_bf16(v0[2], v0[3]); w.z = cvt_pk_bf16(v1[0], v1[1]); w.w = cvt_pk_bf16(v1[2], v1[3]);
                    *(u32x4*)(rowp + bj * HALF) = w; }
            }
    }
};
struct EpiResid {
    static constexpr bool PERM = true, AFTER_DRAIN = false, APERM = false;
    bf16_t* xb; float* ssq; float* yout;
    __device__ __forceinline__ void operator()(const f32x4 (&acc)[2][2][4][2], const Unit& u, int wr, int wc, int fr, int fq) const {
        const unsigned row0 = (unsigned)(u.pm * BM + wr * 64 + fr), col0 = (unsigned)(u.pn * BM + wc * 32 + 8 * fq);
        u32x4 xw[2][4][2];
#pragma unroll
        for (int ai = 0; ai < 2; ++ai)
#pragma unroll
            for (int m = 0; m < 4; ++m)
#pragma unroll
                for (int bj = 0; bj < 2; ++bj) xw[ai][m][bj] = *(const u32x4*)((const char*)xb + ((row0 + ai * HALF + m * 16) * 1024u + col0 + bj * HALF) * 2u);
#pragma unroll
        for (int ai = 0; ai < 2; ++ai)
#pragma unroll
            for (int m = 0; m < 4; ++m) {
                const unsigned row = row0 + ai * HALF + m * 16; const unsigned off = row * 1024u + col0; float s = 0.f;
#pragma unroll
                for (int bj = 0; bj < 2; ++bj) {
                    const u32x4 x = xw[ai][m][bj];
                    f32x4 o0 = acc[ai][bj][m][0], o1 = acc[ai][bj][m][1];
                    o0[0] += __builtin_bit_cast(float, x.x << 16); o0[1] += __builtin_bit_cast(float, x.x & 0xffff0000u); o0[2] += __builtin_bit_cast(float, x.y << 16); o0[3] += __builtin_bit_cast(float, x.y & 0xffff0000u);
                    o1[0] += __builtin_bit_cast(float, x.z << 16); o1[1] += __builtin_bit_cast(float, x.z & 0xffff0000u); o1[2] += __builtin_bit_cast(float, x.w << 16); o1[3] += __builtin_bit_cast(float, x.w & 0xffff0000u);
                    s += ((o0[0] * o0[0] + o0[1] * o0[1]) + (o0[2] * o0[2] + o0[3] * o0[3])) + ((o1[0] * o1[0] + o1[1] * o1[1]) + (o1[2] * o1[2] + o1[3] * o1[3]));
                    u32x4 w; w.x = cvt_pk_bf16(o0[0], o0[1]); w.y = cvt_pk_bf16(o0[2], o0[3]); w.z = cvt_pk_bf16(o1[0], o1[1]); w.w = cvt_pk_bf16(o1[2], o1[3]);
                    *(u32x4*)((char*)xb + (off + bj * HALF) * 2u) = w;
                    if (yout) { *(f32x4*)((char*)yout + (off + bj * HALF) * 4u) = o0; *(f32x4*)((char*)yout + (off + bj * HALF + 4u) * 4u) = o1; }
                }
                s += __shfl_xor(s, 16); s += __shfl_xor(s, 32);
                if (fq == 0) ssq[(size_t)row * 16 + u.pn * 4 + wc] = s;
            }
    }
};

__device__ __forceinline__ float dpp_prev(float oldv, float srcv, const int ctrl_is_2) {
    return ctrl_is_2 ? __builtin_bit_cast(float, __builtin_amdgcn_update_dpp(__builtin_bit_cast(int, oldv), __builtin_bit_cast(int, srcv), 0x112, 0xf, 0xf, false))
                     : __builtin_bit_cast(float, __builtin_amdgcn_update_dpp(__builtin_bit_cast(int, oldv), __builtin_bit_cast(int, srcv), 0x111, 0xf, 0xf, false));
}
__device__ __forceinline__ float dpp_ror1(float v) { return __builtin_bit_cast(float, __builtin_amdgcn_update_dpp(0, __builtin_bit_cast(int, v), 0x121, 0xf, 0xf, false)); }
__device__ __forceinline__ float dpp_ror2(float v) { return __builtin_bit_cast(float, __builtin_amdgcn_update_dpp(0, __builtin_bit_cast(int, v), 0x122, 0xf, 0xf, false)); }
__device__ __forceinline__ float gelu_t(float x) { const float x2 = x * x; const float t = __builtin_fmaf(x2, -0.1029432f, -2.3022082f);
    const float e = __builtin_amdgcn_exp2f(t * x); return x * __builtin_amdgcn_rcpf(1.0f + e); }
struct EpiFfn {
    static constexpr bool PERM = true, AFTER_DRAIN = false, APERM = true;
    bf16_t* G; const float* ssq; const float* cw; const float* cb; float* hb; float* pfc;
    __device__ __forceinline__ void operator()(f32x4 (&acc)[2][2][4][2], const Unit& u, int wr, int wc, int fr, int fq) const {
        const unsigned base0 = (unsigned)(u.pm * BM + wr * 64), row0 = base0 + 4u * fr, cc0 = (unsigned)(u.pn * 128 + wc * 32 + 8 * fq);
        f32x4 wt[2][3], bs[2];
        {
            f32x4 pp[2][4];
#pragma unroll
            for (int ai = 0; ai < 2; ++ai)
#pragma unroll
                for (int m = 0; m < 4; ++m) pp[ai][m] = *(const f32x4*)((const char*)ssq + ((row0 + ai * HALF + m) * 16u + 4u * fq) * 4u);
#pragma unroll
            for (int hf = 0; hf < 2; ++hf) {
#pragma unroll
                for (int jx = 0; jx < 3; ++jx) wt[hf][jx] = *(const f32x4*)((const char*)cw + cc0 * 4u + (jx * 6144 + hf * 3072) * 4);
                bs[hf] = *(const f32x4*)((const char*)cb + cc0 * 4u + hf * 3072 * 4); }
#pragma unroll
            for (int ai = 0; ai < 2; ++ai)
#pragma unroll
                for (int m = 0; m < 4; ++m) {
                    const f32x4 p = pp[ai][m];
                    float s = (p[0] + p[1]) + (p[2] + p[3]); s += __shfl_xor(s, 16); s += __shfl_xor(s, 32);
                    const float r = __builtin_amdgcn_rsqf(s * (1.0f / 1024.0f) + 1e-6f);
#pragma unroll
                    for (int bj = 0; bj < 2; ++bj)
#pragma unroll
                        for (int n = 0; n < 2; ++n) acc[ai][bj][m][n] *= r;
                }
        }
        __builtin_amdgcn_sched_barrier(0);
#pragma unroll
        for (int ai = 0; ai < 2; ++ai) {
            const unsigned grp = (base0 + ai * HALF) >> 6;
            if (fr == 0) {
#pragma unroll
                for (int m = 0; m < 2; ++m) { const unsigned ob = ((grp * 4u + m) * 6144u + cc0) * 4u;
#pragma unroll
                    for (int bj = 0; bj < 2; ++bj)
#pragma unroll
                        for (int n = 0; n < 2; ++n) *(f32x4*)((char*)hb + ob + (bj * 3072 + 4 * n) * 4) = acc[ai][bj][m][n]; } }
            if (fr == 15) {
#pragma unroll
                for (int m = 2; m < 4; ++m) { const unsigned ob = ((grp * 4u + m) * 6144u + cc0) * 4u;
#pragma unroll
                    for (int bj = 0; bj < 2; ++bj)
#pragma unroll
                        for (int n = 0; n < 2; ++n) *(f32x4*)((char*)hb + ob + (bj * 3072 + 4 * n) * 4) = acc[ai][bj][m][n];
                    if (((base0 + ai * HALF + 63u) & 4095u) == 4095u) { const unsigned ob2 = ((((base0 + ai * HALF) >> 12) * 2u + (m - 2)) * 6144u + cc0) * 4u;
#pragma unroll
                        for (int bj = 0; bj < 2; ++bj)
#pragma unroll
                            for (int n = 0; n < 2; ++n) *(f32x4*)((char*)pfc + ob2 + (bj * 3072 + 4 * n) * 4) = acc[ai][bj][m][n]; } } }
        }
        __builtin_amdgcn_sched_barrier(0);
#pragma unroll
        for (int n = 0; n < 2; ++n) {
            if (n == 1) {
#pragma unroll
                for (int hf = 0; hf < 2; ++hf) {
#pragma unroll
                    for (int jx = 0; jx < 3; ++jx) wt[hf][jx] = *(const f32x4*)((const char*)cw + (cc0 + 4u) * 4u + (jx * 6144 + hf * 3072) * 4);
                    bs[hf] = *(const f32x4*)((const char*)cb + (cc0 + 4u) * 4u + hf * 3072 * 4); }
            }
#pragma unroll
            for (int ai = 0; ai < 2; ++ai) {
                f32x4 v[4][2];
#pragma unroll
                for (int hf = 0; hf < 2; ++hf) {
                    f32x4 l3, l2;
#pragma unroll
                    for (int i = 0; i < 4; ++i) { l3[i] = dpp_prev(0.f, acc[ai][hf][3][n][i], 0); l2[i] = dpp_prev(0.f, acc[ai][hf][2][n][i], 0); }
                    const f32x4 x0 = acc[ai][hf][0][n], x1 = acc[ai][hf][1][n], x2 = acc[ai][hf][2][n], x3 = acc[ai][hf][3][n];
                    v[0][hf] = bs[hf] + l2 * wt[hf][0] + l3 * wt[hf][1] + x0 * wt[hf][2];
                    v[1][hf] = bs[hf] + l3 * wt[hf][0] + x0 * wt[hf][1] + x1 * wt[hf][2];
                    v[2][hf] = bs[hf] + x0 * wt[hf][0] + x1 * wt[hf][1] + x2 * wt[hf][2];
                    v[3][hf] = bs[hf] + x1 * wt[hf][0] + x2 * wt[hf][1] + x3 * wt[hf][2];
                }
#pragma unroll
                for (int m = 0; m < 4; ++m) {
                    u32x2 w; w.x = cvt_pk_bf16(gelu_t(v[m][0][0]) * v[m][1][0], gelu_t(v[m][0][1]) * v[m][1][1]); w.y = cvt_pk_bf16(gelu_t(v[m][0][2]) * v[m][1][2], gelu_t(v[m][0][3]) * v[m][1][3]);
                    const unsigned gb = ((row0 + ai * HALF + m) * 3072u + cc0 + 4u * n) * 2u;
                    if (m >= 2 || fr > 0) *(u32x2*)((char*)G + gb) = w;
                }
            }
        }
    }
};

template <class Epi, class Sched, bool ALIGN_EPI = false, bool SP2 = false>
__device__ __forceinline__ void gemm_phase(LAS unsigned char* lds, const Gemm g, const Sched& S, const Epi& E, const int tid) {
    const int wid = __builtin_amdgcn_readfirstlane(tid >> 6), lane = tid & 63, wr = wid >> 2, wc = wid & 3, fr = lane & 15, fq = lane >> 4;
    const int K = g.K, nt = K / BK;
    unsigned voffA[2], voffB[2];
#pragma unroll
    for (int i = 0; i < 2; ++i) { int R, C; stage_rc(tid * 16 + i * 8192, R, C); const int Rb = Epi::PERM ? ((R & ~31) + perm32(R & 31)) : R;
        const int Ra = Epi::APERM ? ((R & 64) | ((R & 15) << 2) | ((R >> 4) & 3)) : R;
        voffA[i] = (unsigned)(Ra * K + C) * 2u; voffB[i] = (unsigned)(Rb * K + C) * 2u; }
    const size_t kstep = (size_t)(BK * 2);
    const size_t hstep = (size_t)HALF * K * 2;
    const size_t tstep = 2 * hstep;
    const unsigned ldsw = (unsigned)wid * 1024u;
    const int aoff = lds_byte(wr * 64 + fr, fq * 8), boff = lds_byte(wc * 32 + fr, fq * 8);
#define PG8_SA(b, h) (((b) * 2 + (h)) * HTB)
#define PG8_SB(b, h) ((4 + (b) * 2 + (h)) * HTB)
#define PG8_STAGE(bufoff, gbase, voff) do { _Pragma("unroll") for (int _i = 0; _i < 2; ++_i) \
        __builtin_amdgcn_global_load_lds((const unsigned*)((const char*)(gbase) + (voff)[_i]), (LAS unsigned*)(lds + (bufoff) + ldsw + _i * 8192), 16, 0, 0); } while (0)
#define PG8_LDA(dst, b, h) do { _Pragma("unroll") for (int m = 0; m < 4; ++m) _Pragma("unroll") for (int k = 0; k < 2; ++k) dst[m][k] = *(const LAS bf16x8*)(lds + PG8_SA(b, h) + aoff + m * 2048 + k * 1024); } while (0)
#define PG8_LDB(dst, b, h) do { _Pragma("unroll") for (int n = 0; n < 2; ++n) _Pragma("unroll") for (int k = 0; k < 2; ++k) dst[n][k] = *(const LAS bf16x8*)(lds + PG8_SB(b, h) + boff + n * 2048 + k * 1024); } while (0)
#define PG8_MMA(ai, bj, At, Bt) do { __builtin_amdgcn_s_setprio(1); _Pragma("unroll") for (int m = 0; m < 4; ++m) _Pragma("unroll") for (int n = 0; n < 2; ++n) _Pragma("unroll") for (int k = 0; k < 2; ++k) \
        acc[ai][bj][m][n] = __builtin_amdgcn_mfma_f32_16x16x32_bf16(Bt[n][k], At[m][k], acc[ai][bj][m][n], 0, 0, 0); __builtin_amdgcn_s_setprio(0); } while (0)
#define PG8_WAIT_V(n) asm volatile("s_waitcnt vmcnt(" #n ")" ::: "memory")
#define PG8_WAIT_L(n) asm volatile("s_waitcnt lgkmcnt(" #n ")" ::: "memory")
#define PG8_BAR __builtin_amdgcn_s_barrier()
#define PG8_SCHED __builtin_amdgcn_sched_barrier(0)
    Unit cur, nxt; int ui = 0;
    if (!S.next(0, cur)) return;
    f32x4 acc[2][2][4][2];
#pragma unroll
    for (int a = 0; a < 2; ++a)
#pragma unroll
        for (int b = 0; b < 2; ++b)
#pragma unroll
            for (int m = 0; m < 4; ++m)
#pragma unroll
                for (int n = 0; n < 2; ++n) acc[a][b][m][n] = (f32x4){0.f, 0.f, 0.f, 0.f};
    bf16x8 At[4][2], B0[2][2], B1[2][2];
    const char* cA = (const char*)g.A + (size_t)cur.pm * tstep; const char* cB = (const char*)g.Bt + (size_t)cur.pn * tstep;
    S.a_ready(cur);
    if constexpr (SP2) {
        PG8_STAGE(PG8_SB(0, 0), cB, voffB); PG8_STAGE(PG8_SB(0, 1), cB + hstep, voffB); PG8_STAGE(PG8_SA(0, 0), cA, voffA); PG8_STAGE(PG8_SA(0, 1), cA + hstep, voffA);
        if (wr == 1) PG8_BAR;
        PG8_WAIT_V(2); PG8_BAR;
        PG8_STAGE(PG8_SB(1, 0), cB + kstep, voffB); PG8_STAGE(PG8_SA(1, 0), cA + kstep, voffA); PG8_STAGE(PG8_SB(1, 1), cB + hstep + kstep, voffB);
        PG8_WAIT_V(6); PG8_BAR;
    } else {
        PG8_STAGE(PG8_SB(0, 0), cB, voffB); PG8_STAGE(PG8_SA(0, 0), cA, voffA); PG8_STAGE(PG8_SB(0, 1), cB + hstep, voffB); PG8_STAGE(PG8_SA(0, 1), cA + hstep, voffA);
        if (wr == 1) PG8_BAR;
        PG8_WAIT_V(4); PG8_BAR;
        PG8_STAGE(PG8_SB(1, 0), cB + kstep, voffB); PG8_STAGE(PG8_SA(1, 0), cA + kstep, voffA); PG8_STAGE(PG8_SB(1, 1), cB + hstep + kstep, voffB);
        PG8_WAIT_V(6); PG8_BAR;
    }
    for (;;) {
        const bool has_next = S.next(ui + 1, nxt);
        const char* nA = has_next ? (const char*)g.A + (size_t)nxt.pm * tstep : cA; const char* nB = has_next ? (const char*)g.Bt + (size_t)nxt.pn * tstep : cB;
        for (int t = 0; t < nt; t += 2) {
            const bool last = (t == nt - 2);
            const char* a1 = cA + (size_t)(t + 1) * kstep;
            const char* a2 = last ? nA : cA + (size_t)(t + 2) * kstep; const char* b2 = last ? nB : cB + (size_t)(t + 2) * kstep;
            const char* a3 = a2 + kstep; const char* b3 = b2 + kstep;
            if (last && has_next) S.a_ready(nxt);
            if constexpr (SP2) {
            PG8_LDB(B0, 0, 0); PG8_LDB(B1, 0, 1); PG8_SCHED; PG8_LDA(At, 0, 0); PG8_STAGE(PG8_SA(1, 1), a1 + hstep, voffA);
            PG8_WAIT_V(8); PG8_WAIT_L(0); PG8_BAR; PG8_MMA(0, 0, At, B0); PG8_MMA(0, 1, At, B1); PG8_BAR; PG8_SCHED;
            PG8_LDA(At, 0, 1); PG8_STAGE(PG8_SB(0, 0), b2, voffB); PG8_STAGE(PG8_SB(0, 1), b2 + hstep, voffB); PG8_STAGE(PG8_SA(0, 0), a2, voffA);
            PG8_WAIT_V(8); PG8_WAIT_L(0); PG8_BAR; PG8_MMA(1, 0, At, B0); PG8_MMA(1, 1, At, B1); PG8_BAR; PG8_SCHED;
            PG8_LDB(B0, 1, 0); PG8_LDB(B1, 1, 1); PG8_SCHED; PG8_LDA(At, 1, 0); PG8_STAGE(PG8_SA(0, 1), a2 + hstep, voffA);
            PG8_WAIT_V(8); PG8_WAIT_L(0); PG8_BAR; PG8_MMA(0, 0, At, B0); PG8_MMA(0, 1, At, B1); PG8_BAR; PG8_SCHED;
            PG8_LDA(At, 1, 1); PG8_STAGE(PG8_SB(1, 0), b3, voffB); PG8_STAGE(PG8_SB(1, 1), b3 + hstep, voffB); PG8_STAGE(PG8_SA(1, 0), a3, voffA);
            PG8_WAIT_V(8); PG8_WAIT_L(0); PG8_BAR; PG8_MMA(1, 0, At, B0); PG8_MMA(1, 1, At, B1); PG8_BAR; PG8_SCHED;
            } else {
            PG8_LDB(B0, 0, 0); PG8_SCHED; PG8_LDA(At, 0, 0); PG8_STAGE(PG8_SA(1, 1), a1 + hstep, voffA);
            PG8_WAIT_L(8); PG8_BAR; PG8_WAIT_L(0); PG8_MMA(0, 0, At, B0); PG8_BAR; PG8_SCHED;
            PG8_LDB(B1, 0, 1); PG8_STAGE(PG8_SB(0, 0), b2, voffB);
            PG8_BAR; PG8_WAIT_L(0); PG8_MMA(0, 1, At, B1); PG8_BAR;
            PG8_LDA(At, 0, 1); PG8_STAGE(PG8_SA(0, 0), a2, voffA);
            PG8_BAR; PG8_WAIT_L(0); PG8_MMA(1, 0, At, B0); PG8_BAR; PG8_SCHED;
            PG8_STAGE(PG8_SB(0, 1), b2 + hstep, voffB);
            PG8_WAIT_V(6); PG8_BAR; PG8_MMA(1, 1, At, B1); PG8_BAR;
            PG8_LDB(B0, 1, 0); PG8_SCHED; PG8_LDA(At, 1, 0); PG8_STAGE(PG8_SA(0, 1), a2 + hstep, voffA);
            PG8_WAIT_L(8); PG8_BAR; PG8_WAIT_L(0); PG8_MMA(0, 0, At, B0); PG8_BAR; PG8_SCHED;
            PG8_LDB(B1, 1, 1); PG8_STAGE(PG8_SB(1, 0), b3, voffB);
            PG8_BAR; PG8_WAIT_L(0); PG8_MMA(0, 1, At, B1); PG8_BAR;
            PG8_LDA(At, 1, 1); PG8_STAGE(PG8_SA(1, 0), a3, voffA);
            PG8_BAR; PG8_WAIT_L(0); PG8_MMA(1, 0, At, B0); PG8_BAR; PG8_SCHED;
            PG8_STAGE(PG8_SB(1, 1), b3 + hstep, voffB);
            PG8_WAIT_V(6); PG8_BAR; PG8_MMA(1, 1, At, B1); PG8_BAR;
            }
        }
        if constexpr (ALIGN_EPI) { if (wr == 0) PG8_BAR; }
        if constexpr (!Epi::AFTER_DRAIN) { E(acc, cur, wr, wc, fr, fq); S.done(cur); }
        if (!has_next) break;
#pragma unroll
        for (int a = 0; a < 2; ++a)
#pragma unroll
            for (int b = 0; b < 2; ++b)
#pragma unroll
                for (int m = 0; m < 4; ++m)
#pragma unroll
                    for (int n = 0; n < 2; ++n) acc[a][b][m][n] = (f32x4){0.f, 0.f, 0.f, 0.f};
        cur = nxt; cA = nA; cB = nB; ++ui;
        if constexpr (ALIGN_EPI) { if (wr == 1) PG8_BAR; }
    }
    PG8_WAIT_V(0);
    if constexpr (!ALIGN_EPI) { if (wr == 0) PG8_BAR; }
    PG8_BAR;
#undef PG8_SA
#undef PG8_SB
#undef PG8_STAGE
#undef PG8_LDA
#undef PG8_LDB
#undef PG8_MMA
#undef PG8_WAIT_V
#undef PG8_WAIT_L
#undef PG8_BAR
#undef PG8_SCHED
}
}

constexpr int DM = 1024, SEQ = 4096, NBATCH = 4, MP = 16384, MS = 128, DFF = 3072, DRNN = 768;
constexpr int NTHREADS = 512, NWAVES = 8;
constexpr int LDS_BYTES = 147456;
constexpr size_t O_YP = 0, O_YS = 16777216, O_PH = 16908288, O_PRC = 16914432, O_PFC = 16932864, O_PK = 17129472, O_PV = 17260544,
                 O_PMK = 17391616, O_PMV = 18440192, O_SH = 19488768, O_SRC = 19685376, O_SFC = 20275200, O_SK = 26566656, O_SV = 26599424, O_END = 26632192;
constexpr size_t MiB = 1u << 20;
constexpr size_t WS_WINA = 0, WS_WINB0 = 8 * MiB, WS_WINB1 = 12 * MiB, WS_WOUT = 16 * MiB, WS_WUP = 24 * MiB, WS_WDN = 72 * MiB, WS_WMKV = 96 * MiB;
constexpr size_t WS_XB = 104 * MiB, WS_SSQ = 140 * MiB, WS_SSQS = 141 * MiB, WS_MEMSSQ = 141 * MiB + 512 * 1024, WS_MEMXB = 142 * MiB, WS_MEMRAW = 144 * MiB;
constexpr size_t WS_MK = 148 * MiB, WS_MVT = 150 * MiB, WS_ROPEC = 152 * MiB, WS_ROPES = 153 * MiB, WS_CARA = 154 * MiB, WS_CARB = 155 * MiB, WS_UINS = 156 * MiB;
constexpr size_t WS_WG = 157 * MiB;
constexpr size_t WS_HB = 356 * MiB + 128 * MiB;
constexpr size_t WS_CTL = 141 * MiB + 256 * 1024;
constexpr size_t WS_MIX = 160 * MiB, WS_UIN = 196 * MiB, WS_G = 256 * MiB, WS_U = 356 * MiB, WS_END = 548 * MiB;

struct KArgs { const float* in[35]; float* out; unsigned char* ws; int ph_lo, ph_hi; };
constexpr int ARGTAB_OFF = LDS_BYTES - 512;
struct Args {
    LAS const unsigned* t;
    __device__ __forceinline__ unsigned long long ld(int i) const { const unsigned lo = __builtin_amdgcn_readfirstlane(t[2 * i]), hi = __builtin_amdgcn_readfirstlane(t[2 * i + 1]); return ((unsigned long long)hi << 32) | lo; }
    __device__ __forceinline__ const float* in_(int i) const { return (const float*)ld(i); }
    __device__ __forceinline__ float* out_() const { return (float*)ld(35); }
    __device__ __forceinline__ unsigned char* ws_() const { return (unsigned char*)ld(36); }
};
enum { I_XP = 0, I_XS, I_SH, I_SRC, I_SFC, I_CSK, I_CSV, I_CMK, I_CMV, I_MEMP, I_NMG, I_NFG, I_WINA, I_RCW, I_RCB, I_WGX, I_BGX, I_WGA, I_BGA, I_LRU,
       I_WINB, I_QNG, I_SINK, I_KVNG, I_WKV, I_KNG, I_MNG, I_WMKV, I_MQNG, I_MKNG, I_WOUT, I_WUP, I_FCW, I_FCB, I_WDN };

__device__ __forceinline__ unsigned f2bf(float f) { unsigned u = __builtin_bit_cast(unsigned, f); return (u + 0x7fffu + ((u >> 16) & 1u)) >> 16; }
__device__ __forceinline__ unsigned pk2(float lo, float hi) { return f2bf(lo) | (f2bf(hi) << 16); }
__device__ __forceinline__ float bf2f(unsigned b) { return __builtin_bit_cast(float, b << 16); }
__device__ __forceinline__ float bflo(unsigned w) { return __builtin_bit_cast(float, w << 16); }
__device__ __forceinline__ float bfhi(unsigned w) { return __builtin_bit_cast(float, w & 0xffff0000u); }
__device__ __forceinline__ float gelu_tanh(float x) { const float x2 = x * x; const float t = __builtin_fmaf(x2, -0.1029432f, -2.3022082f); const float e = __builtin_amdgcn_exp2f(t * x); return x * __builtin_amdgcn_rcpf(1.0f + e); }
__device__ __forceinline__ float sigmoidf_(float x) { return __builtin_amdgcn_rcpf(1.0f + __builtin_amdgcn_exp2f(-1.4426950408889634f * x)); }
__device__ __forceinline__ float wave_sum(float v) {
#pragma unroll
    for (int o = 1; o < 64; o <<= 1) v += __shfl_xor(v, o);
    return v;
}
__device__ __forceinline__ float wave_max(float v) {
#pragma unroll
    for (int o = 1; o < 64; o <<= 1) v = fmaxf(v, __shfl_xor(v, o));
    return v;
}
__device__ __forceinline__ f32x4 mfma16(bf16x8 a, bf16x8 b, f32x4 c) { return __builtin_amdgcn_mfma_f32_16x16x32_bf16(a, b, c, 0, 0, 0); }

struct WDesc { const float* W; const float* gain; bf16_t* WT; int K, N, pair; };
__device__ __forceinline__ WDesc wdesc(const Args& a, int mi) {
    WDesc d; unsigned char* ws = a.ws_(); d.pair = 0;
    if (mi < 2)       { d.W = a.in_(I_WINA) + (size_t)mi * DM * 1792; d.gain = a.in_(I_NMG) + mi * DM; d.WT = (bf16_t*)(ws + WS_WINA) + (size_t)mi * 1792 * DM; d.K = DM; d.N = 1792; }
    else if (mi == 2) { d.W = a.in_(I_WINB); d.gain = a.in_(I_NMG) + 2 * DM; d.WT = (bf16_t*)(ws + WS_WINB0); d.K = DM; d.N = 1024; }
    else if (mi == 3) { d.W = a.in_(I_WKV); d.gain = a.in_(I_KVNG); d.WT = (bf16_t*)(ws + WS_WINB0) + (size_t)1024 * DM; d.K = DM; d.N = 512; }
    else if (mi == 4) { d.W = a.in_(I_WINB) + (size_t)DM * 1024; d.gain = a.in_(I_NMG) + 3 * DM; d.WT = (bf16_t*)(ws + WS_WINB1); d.K = DM; d.N = 1024; }
    else if (mi < 9)  { const int l = mi - 5;  d.W = a.in_(I_WOUT) + (size_t)l * DM * DM; d.gain = nullptr; d.WT = (bf16_t*)(ws + WS_WOUT) + (size_t)l * DM * DM; d.K = DM; d.N = DM; }
    else if (mi < 13) { const int l = mi - 9;  d.W = a.in_(I_WUP) + (size_t)l * DM * 6144; d.gain = a.in_(I_NFG) + l * DM; d.WT = (bf16_t*)(ws + WS_WUP) + (size_t)l * 6144 * DM; d.K = DM; d.N = 6144; d.pair = 1; }
    else if (mi < 17) { const int l = mi - 13; d.W = a.in_(I_WDN) + (size_t)l * DFF * DM; d.gain = nullptr; d.WT = (bf16_t*)(ws + WS_WDN) + (size_t)l * DM * DFF; d.K = DFF; d.N = DM; }
    else              { const int l = mi - 17; d.W = a.in_(I_WMKV) + (size_t)l * DM * 512; d.gain = a.in_(I_MNG) + l * DM; d.WT = (bf16_t*)(ws + WS_WMKV) + (size_t)l * 512 * DM; d.K = DM; d.N = 512; }
    return d;
}
__device__ __forceinline__ void transpose_item(const WDesc& d, LAS float* scr, int item, int tid) {
    const int nblk = d.N / 128, kb = item / nblk, nb = item % nblk, k0 = 128 * kb, n0 = 128 * nb;
    {
        const int c4 = tid & 31, r0 = tid >> 5;
#pragma unroll
        for (int p = 0; p < 8; ++p) { const int kk = r0 + 16 * p;
            f32x4 v = *(const f32x4*)(d.W + (size_t)(k0 + kk) * d.N + n0 + 4 * c4);
            if (d.gain) v *= d.gain[k0 + kk];
            LAS float* s = scr + kk * 129 + 4 * c4; s[0] = v[0]; s[1] = v[1]; s[2] = v[2]; s[3] = v[3]; }
    }
    __syncthreads();
    {
        const int c = tid & 15, nr = tid >> 4;
#pragma unroll
        for (int p = 0; p < 4; ++p) { const int n = nr + 32 * p; const LAS float* s = scr + (8 * c) * 129 + n;
            u32x4 o; o.x = pk2(s[0 * 129], s[1 * 129]); o.y = pk2(s[2 * 129], s[3 * 129]); o.z = pk2(s[4 * 129], s[5 * 129]); o.w = pk2(s[6 * 129], s[7 * 129]);
            int orow = n0 + n; if (d.pair) { const int hf = orow / DFF, cc = orow % DFF; orow = (cc >> 7) * 256 + hf * 128 + (cc & 127); }
            *(u32x4*)(d.WT + (size_t)orow * d.K + k0 + 8 * c) = o; }
    }
    __syncthreads();
}
__device__ __forceinline__ void row_to_bf16(const float* xrow, bf16_t* orow, float* ssq, int nslot, int lane) {
    const f32x4* xr = (const f32x4*)xrow + lane; float s = 0.f;
    unsigned long long* o8 = (unsigned long long*)orow + lane;
#pragma unroll
    for (int j = 0; j < 4; ++j) { const f32x4 v = xr[64 * j]; s += (v[0] * v[0] + v[1] * v[1]) + (v[2] * v[2] + v[3] * v[3]);
        o8[64 * j] = (unsigned long long)pk2(v[0], v[1]) | ((unsigned long long)pk2(v[2], v[3]) << 32); }
    s = wave_sum(s);
    if (lane < nslot) ssq[lane] = (lane == 0) ? s : 0.f;
}
__device__ __forceinline__ void prologue(const Args& a, LAS unsigned char* L, int gw, int NGW, int wave, int lane) {
    LAS float* scr = (LAS float*)L;
    {
        const int G = NGW / NWAVES, bid = gw % G, tid = wave * 64 + lane;
        int it = bid, mi = 0, base = 0;
        WDesc d = wdesc(a, 0); int cnt = (d.K / 128) * (d.N / 128);
        while (mi < 21) {
            if (it < base + cnt) { transpose_item(d, scr, it - base, tid); it += G; }
            else { base += cnt; ++mi; if (mi < 21) { d = wdesc(a, mi); cnt = (d.K / 128) * (d.N / 128); } }
        }
    }
    unsigned char* ws = a.ws_();
    for (int m = gw; m < MP + MS + 1024; m += NGW) {
        if (m < MP) row_to_bf16(a.in_(I_XP) + (size_t)m * DM, (bf16_t*)(ws + WS_XB) + (size_t)m * DM, (float*)(ws + WS_SSQ) + (size_t)m * 16, 16, lane);
        else if (m < MP + MS) { const int r = m - MP; row_to_bf16(a.in_(I_XS) + (size_t)r * DM, (bf16_t*)(ws + WS_XB) + (size_t)m * DM, (float*)(ws + WS_SSQS) + (size_t)r * 32, 32, lane); }
        else { const int r = m - MP - MS; row_to_bf16(a.in_(I_MEMP) + (size_t)r * DM, (bf16_t*)(ws + WS_MEMXB) + (size_t)r * DM, (float*)(ws + WS_MEMSSQ) + (size_t)r * 16, 16, lane); }
    }
    {
        bf16_t* wg = (bf16_t*)(ws + WS_WG);
        for (int idx = gw * 64 + lane; idx < 2 * 12 * 2 * 4096; idx += NGW * 64) {
            const int k = idx & 63, j = (idx >> 6) & 63, g = (idx >> 12) & 1, ln = idx >> 13;
            const float* wsrc = (g ? a.in_(I_WGA) : a.in_(I_WGX)) + (size_t)ln * 4096;
            wg[idx] = (bf16_t)f2bf(wsrc[k * 64 + j]);
        }
    }
    float* rc = (float*)(ws + WS_ROPEC); float* rs = (float*)(ws + WS_ROPES);
    for (int idx = gw * 64 + lane; idx < 4097 * 32; idx += NGW * 64) {
        const int p = idx >> 5, i = idx & 31; const double pos = (p == 4096) ? 8192.0 : (double)p;
        double inv = 1.0; for (int k = 0; k < i; ++k) inv *= 0.74989420933245582;
        const double ang = pos * inv; const double n = __builtin_rint(ang * 0.63661977236758134); const double r = ang - n * 1.5707963267948966;
        const double r2 = r * r;
        const double sn = r * (1.0 + r2 * (-1.0 / 6 + r2 * (1.0 / 120 + r2 * (-1.0 / 5040 + r2 * (1.0 / 362880 - r2 * (1.0 / 39916800))))));
        const double cs = 1.0 + r2 * (-0.5 + r2 * (1.0 / 24 + r2 * (-1.0 / 720 + r2 * (1.0 / 40320 - r2 * (1.0 / 3628800)))));
        const int qd = ((int)n) & 3; double c, s;
        if (qd == 0) { c = cs; s = sn; } else if (qd == 1) { c = -sn; s = cs; } else if (qd == 2) { c = -cs; s = -sn; } else { c = sn; s = -cs; }
        rc[idx] = (float)c; rs[idx] = (float)s;
    }
}

__device__ __forceinline__ void memkv_finalize(const Args& a, int gw, int NGW, int lane) {
    unsigned char* ws = a.ws_();
    for (int t = gw; t < 4 * 1024; t += NGW) {
        const int l = t >> 10, row = t & 1023, b = row >> 8, m = row & 255;
        const bf16_t* raw = (const bf16_t*)(ws + WS_MEMRAW) + (size_t)t * 512;
        const u32x4 w = *(const u32x4*)(raw + lane * 8);
        float v[8] = { bflo(w.x), bfhi(w.x), bflo(w.y), bfhi(w.y), bflo(w.z), bfhi(w.z), bflo(w.w), bfhi(w.w) };
        float s = 0.f;
#pragma unroll
        for (int e = 0; e < 8; ++e) s += v[e] * v[e];
        s += __shfl_xor(s, 1); s += __shfl_xor(s, 2); s += __shfl_xor(s, 4);
        const int h = (lane >> 3) & 3, d0 = (lane & 7) * 8;
        if (lane < 32) {
            const float r = 1.0f / sqrtf(s * (1.0f / 64.0f) + 1e-6f); const float* g = a.in_(I_MKNG) + l * 64 + d0;
#pragma unroll
            for (int e = 0; e < 8; ++e) v[e] = v[e] * r * g[e];
            float* o = a.out_() + O_PMK + ((size_t)(l * 4 + b) * 256 + m) * 256 + h * 64 + d0;
            *(f32x4*)o = (f32x4){v[0], v[1], v[2], v[3]}; *(f32x4*)(o + 4) = (f32x4){v[4], v[5], v[6], v[7]};
            u32x4 p; p.x = pk2(v[0], v[1]); p.y = pk2(v[2], v[3]); p.z = pk2(v[4], v[5]); p.w = pk2(v[6], v[7]);
            *(u32x4*)((bf16_t*)(ws + WS_MK) + ((size_t)((l * 4 + b) * 4 + h) * 256 + m) * 64 + d0) = p;
        } else {
            float* o = a.out_() + O_PMV + ((size_t)(l * 4 + b) * 256 + m) * 256 + h * 64 + d0;
            *(f32x4*)o = (f32x4){v[0], v[1], v[2], v[3]}; *(f32x4*)(o + 4) = (f32x4){v[4], v[5], v[6], v[7]};
            bf16_t* vt = (bf16_t*)(ws + WS_MVT) + ((size_t)((l * 4 + b) * 4 + h) * 64 + d0) * 256 + m;
#pragma unroll
            for (int e = 0; e < 8; ++e) vt[e * 256] = (bf16_t)f2bf(v[e]);
        }
    }
}

template <class F>
__device__ __forceinline__ void small_gemm(LAS unsigned char* L, const bf16_t* A, const bf16_t* Bt, int K, int ncg, int cstride, int c1off, int tilemap, int bid, int G, int wave, int lane, const F& f) {
    const int fr = lane & 15, q = lane >> 4;
    const int kw = K >> 3;
    LAS f32x4* red = (LAS f32x4*)L;
    for (int task = bid; task < 8 * ncg; task += G) {
        const int rg = task & 7, cgi = task >> 3, ccol = cgi * cstride, n0 = tilemap ? (cgi >> 3) * 256 + (cgi & 7) * 16 : ccol;
        const bf16_t* ap = A + (size_t)(rg * 16 + fr) * K + wave * kw + 8 * q;
        const bf16_t* b0p = Bt + (size_t)(n0 + fr) * K + wave * kw + 8 * q; const bf16_t* b1p = b0p + (size_t)c1off * K;
        f32x4 acc0 = (f32x4){0.f, 0.f, 0.f, 0.f}, acc1 = acc0;
        if (kw == 384) {
            bf16x8 av[12], b0[12], b1[12];
#pragma unroll
            for (int u = 0; u < 12; ++u) { av[u] = *(const bf16x8*)(ap + 32 * u); b0[u] = *(const bf16x8*)(b0p + 32 * u); b1[u] = *(const bf16x8*)(b1p + 32 * u); }
#pragma unroll
            for (int u = 0; u < 12; ++u) { acc0 = mfma16(b0[u], av[u], acc0); acc1 = mfma16(b1[u], av[u], acc1); }
        } else
        for (int k = 0; k < kw; k += 128) {
            bf16x8 av[4], b0[4], b1[4];
#pragma unroll
            for (int u = 0; u < 4; ++u) { av[u] = *(const bf16x8*)(ap + k + 32 * u); b0[u] = *(const bf16x8*)(b0p + k + 32 * u); b1[u] = *(const bf16x8*)(b1p + k + 32 * u); }
#pragma unroll
            for (int u = 0; u < 4; ++u) { acc0 = mfma16(b0[u], av[u], acc0); acc1 = mfma16(b1[u], av[u], acc1); }
        }
        red[(wave * 2 + 0) * 64 + lane] = acc0; red[(wave * 2 + 1) * 64 + lane] = acc1;
        __syncthreads();
        if (wave == 0) {
#pragma unroll
            for (int w = 1; w < 8; ++w) { acc0 += red[(w * 2 + 0) * 64 + lane]; acc1 += red[(w * 2 + 1) * 64 + lane]; }
            f(acc0, acc1, rg * 16 + fr, ccol, q);
        }
        __syncthreads();
    }
}
template <class F>
__device__ __forceinline__ void small_gemm128(LAS unsigned char* L, const bf16_t* A, const bf16_t* Bt, int ncg, int bid, int G, int wave, int lane, const F& f) {
    constexpr int K = 1024;
    const int fr = lane & 15, q = lane >> 4, rh = wave & 1, kq = wave >> 1;
    LAS f32x4* red = (LAS f32x4*)L;
    for (int task = bid; task < ncg; task += G) {
        const int n0 = (task >> 3) * 256 + (task & 7) * 16;
        const bf16_t* ap = A + (size_t)(rh * 64 + fr) * K + kq * 256 + 8 * q;
        const bf16_t* b0p = Bt + (size_t)(n0 + fr) * K + kq * 256 + 8 * q; const bf16_t* b1p = b0p + (size_t)128 * K;
        f32x4 acc[4][2];
#pragma unroll
        for (int fi = 0; fi < 4; ++fi) { acc[fi][0] = (f32x4){0.f, 0.f, 0.f, 0.f}; acc[fi][1] = acc[fi][0]; }
#pragma unroll
        for (int kb = 0; kb < 2; ++kb) {
            bf16x8 av[4][4], b0[4], b1[4];
#pragma unroll
            for (int u = 0; u < 4; ++u) { const int k = kb * 128 + 32 * u; b0[u] = *(const bf16x8*)(b0p + k); b1[u] = *(const bf16x8*)(b1p + k);
#pragma unroll
                for (int fi = 0; fi < 4; ++fi) av[fi][u] = *(const bf16x8*)(ap + (size_t)fi * 16 * K + k); }
#pragma unroll
            for (int u = 0; u < 4; ++u)
#pragma unroll
                for (int fi = 0; fi < 4; ++fi) { acc[fi][0] = mfma16(b0[u], av[fi][u], acc[fi][0]); acc[fi][1] = mfma16(b1[u], av[fi][u], acc[fi][1]); }
        }
#pragma unroll
        for (int fi = 0; fi < 4; ++fi) { red[((((rh * 4 + kq) * 4 + fi) * 2) + 0) * 64 + lane] = acc[fi][0]; red[((((rh * 4 + kq) * 4 + fi) * 2) + 1) * 64 + lane] = acc[fi][1]; }
        __syncthreads();
        {
            const int erh = wave >> 2, efi = wave & 3;
            f32x4 s0 = (f32x4){0.f, 0.f, 0.f, 0.f}, s1 = s0;
#pragma unroll
            for (int k2 = 0; k2 < 4; ++k2) { s0 += red[((((erh * 4 + k2) * 4 + efi) * 2) + 0) * 64 + lane]; s1 += red[((((erh * 4 + k2) * 4 + efi) * 2) + 1) * 64 + lane]; }
            f(s0, s1, (erh * 4 + efi) * 16 + fr, task * 16, q);
        }
        __syncthreads();
    }
}
__device__ __forceinline__ float sample_rstd(const float* ssqs, int row, int q) {
    const f32x4 p0 = *(const f32x4*)(ssqs + row * 32 + 8 * q), p1 = *(const f32x4*)(ssqs + row * 32 + 8 * q + 4);
    float s = ((p0[0] + p0[1]) + (p0[2] + p0[3])) + ((p1[0] + p1[1]) + (p1[2] + p1[3]));
    s += __shfl_xor(s, 16); s += __shfl_xor(s, 32);
    return 1.0f / sqrtf(s * (1.0f / 1024.0f) + 1e-6f);
}
struct SEpiScale {
    float* O; const float* ssqs;
    __device__ __forceinline__ void operator()(f32x4 a0, f32x4 a1, int row, int n0, int q) const {
        const float r = sample_rstd(ssqs, row, q);
        *(f32x4*)(O + (size_t)row * 1792 + n0 + 4 * q) = a0 * r; *(f32x4*)(O + (size_t)row * 1792 + n0 + 16 + 4 * q) = a1 * r;
    }
};
struct SEpiResid {
    const float* xin; float* xout; bf16_t* xb; float* ssqs;
    __device__ __forceinline__ void operator()(f32x4 a0, f32x4 a1, int row, int n0, int q) const {
        const size_t o0 = (size_t)row * 1024 + n0 + 4 * q, o1 = o0 + 16;
        const f32x4 x0 = *(const f32x4*)(xin + o0) + a0, x1 = *(const f32x4*)(xin + o1) + a1;
        *(f32x4*)(xout + o0) = x0; *(f32x4*)(xout + o1) = x1;
        u32x2 w; w.x = pk2(x0[0], x0[1]); w.y = pk2(x0[2], x0[3]); *(u32x2*)(xb + o0) = w;
        w.x = pk2(x1[0], x1[1]); w.y = pk2(x1[2], x1[3]); *(u32x2*)(xb + o1) = w;
        float s = ((x0[0] * x0[0] + x0[1] * x0[1]) + (x0[2] * x0[2] + x0[3] * x0[3])) + ((x1[0] * x1[0] + x1[1] * x1[1]) + (x1[2] * x1[2] + x1[3] * x1[3]));
        s += __shfl_xor(s, 16); s += __shfl_xor(s, 32);
        if (q == 0) ssqs[row * 32 + (n0 >> 5)] = s;
    }
};
struct SEpiFfn {
    const float* st; const float* cw; const float* cb; float* sfc; bf16_t* G; const float* ssqs;
    __device__ __forceinline__ void operator()(f32x4 a0, f32x4 a1, int row, int n0, int q) const {
        const float r = sample_rstd(ssqs, row, q);
        const int c = n0 + 4 * q;
        f32x4 u[2] = { a0 * r, a1 * r }; f32x4 v[2];
#pragma unroll
        for (int hf = 0; hf < 2; ++hf) {
            const int cc = c + hf * DFF;
            const f32x4 s0 = __builtin_nontemporal_load((const f32x4*)(st + ((size_t)row * 2 + 0) * 6144 + cc)), s1 = __builtin_nontemporal_load((const f32x4*)(st + ((size_t)row * 2 + 1) * 6144 + cc));
            const f32x4 w0 = *(const f32x4*)(cw + cc), w1 = *(const f32x4*)(cw + 6144 + cc), w2 = *(const f32x4*)(cw + 2 * 6144 + cc), bb = *(const f32x4*)(cb + cc);
            v[hf] = s0 * w0 + s1 * w1 + u[hf] * w2 + bb;
            *(f32x4*)(sfc + ((size_t)row * 2 + 0) * 6144 + cc) = s1; *(f32x4*)(sfc + ((size_t)row * 2 + 1) * 6144 + cc) = u[hf];
        }
        u32x2 w; w.x = pk2(gelu_tanh(v[0][0]) * v[1][0], gelu_tanh(v[0][1]) * v[1][1]); w.y = pk2(gelu_tanh(v[0][2]) * v[1][2], gelu_tanh(v[0][3]) * v[1][3]);
        *(u32x2*)(G + (size_t)(MP + row) * DFF + c) = w;
    }
};

__device__ __forceinline__ void unpack8(const u32x4 w, float (&v)[8]) { v[0] = bflo(w.x); v[1] = bfhi(w.x); v[2] = bflo(w.y); v[3] = bfhi(w.y); v[4] = bflo(w.z); v[5] = bfhi(w.z); v[6] = bflo(w.w); v[7] = bfhi(w.w); }
__device__ __forceinline__ void rglru_item(const Args& a, LAS unsigned char* L, int l, int mode, int item, bool sample, const int tid) {
    const int lane = tid & 63, wave = tid >> 6;
    unsigned char* ws = a.ws_();
    LAS float* xs = (LAS float*)L;
    LAS float* Bx = xs;
    LAS float* xcf = (LAS float*)(L + 33792);
    LAS float* Aa = (LAS float*)(L + 33792 + 32768);
    LAS bf16_t* xcb = (LAS bf16_t*)(L + 33792 + 65536);
    LAS bf16_t* WT = xcb + 128 * 72;
    LAS float* seg = (LAS float*)(L + 33792 + 65536 + 36864);
    LAS float* hin = seg + 1024;
    LAS float* cst = hin + 64;
    int n, c = 0, b = 0;
    if (sample) n = item; else { n = item % 12; const int rest = item / 12; c = rest & 31; b = rest >> 5; }
    const int ch0 = n * 64, t0 = c * 128, row0 = b * SEQ + t0;
    const bf16_t* UIN = (const bf16_t*)(ws + WS_UIN);
    const float* UINS = (const float*)(ws + WS_UINS);
    const float* cw = a.in_(I_RCW) + (size_t)l * 4 * DRNN + ch0; const float* cbias = a.in_(I_RCB) + l * DRNN + ch0;
    {
        const bf16_t* wg = (const bf16_t*)(ws + WS_WG) + (size_t)(l * 12 + n) * 8192;
#pragma unroll
        for (int i = 0; i < 2; ++i) { const int idx = tid + 512 * i, g = idx >> 9, j = (idx >> 3) & 63, c8 = idx & 7;
            *(LAS u32x4*)(WT + g * 64 * 72 + j * 72 + 8 * c8) = *(const u32x4*)(wg + g * 4096 + j * 64 + 8 * c8); }
    }
    if (tid < 64) { cst[tid] = -log1pf(expf(-a.in_(I_LRU)[l * DRNN + ch0 + tid])); cst[64 + tid] = a.in_(I_BGX)[l * DRNN + ch0 + tid]; cst[128 + tid] = a.in_(I_BGA)[l * DRNN + ch0 + tid]; }
    if (!sample) {
        const int cg8 = tid & 7, tq = tid >> 3, tk = 2 * tq;
        float wv[4][8], wbv[8];
#pragma unroll
        for (int jx = 0; jx < 4; ++jx) { const f32x4 p0 = *(const f32x4*)(cw + jx * DRNN + 8 * cg8), p1 = *(const f32x4*)(cw + jx * DRNN + 8 * cg8 + 4);
#pragma unroll
            for (int e2 = 0; e2 < 4; ++e2) { wv[jx][e2] = p0[e2]; wv[jx][4 + e2] = p1[e2]; } }
        { const f32x4 p0 = *(const f32x4*)(cbias + 8 * cg8), p1 = *(const f32x4*)(cbias + 8 * cg8 + 4);
#pragma unroll
          for (int e2 = 0; e2 < 4; ++e2) { wbv[e2] = p0[e2]; wbv[4 + e2] = p1[e2]; } }
        float xr[5][8];
#pragma unroll
        for (int r = 0; r < 5; ++r) { const int t = t0 + tk - 3 + r;
            if (t >= 0) unpack8(*(const u32x4*)(UIN + (size_t)(b * SEQ + t) * 1792 + 768 + ch0 + 8 * cg8), xr[r]);
            else {
#pragma unroll
                for (int e2 = 0; e2 < 8; ++e2) xr[r][e2] = 0.f; } }
#pragma unroll
        for (int tt = 0; tt < 2; ++tt) {
            float xc[8];
#pragma unroll
            for (int e2 = 0; e2 < 8; ++e2) xc[e2] = wbv[e2] + xr[tt][e2] * wv[0][e2] + xr[tt + 1][e2] * wv[1][e2] + xr[tt + 2][e2] * wv[2][e2] + xr[tt + 3][e2] * wv[3][e2];
            *(LAS f32x4*)(xcf + (tk + tt) * 64 + 8 * cg8) = (f32x4){xc[0], xc[1], xc[2], xc[3]}; *(LAS f32x4*)(xcf + (tk + tt) * 64 + 8 * cg8 + 4) = (f32x4){xc[4], xc[5], xc[6], xc[7]};
            u32x4 w; w.x = pk2(xc[0], xc[1]); w.y = pk2(xc[2], xc[3]); w.z = pk2(xc[4], xc[5]); w.w = pk2(xc[6], xc[7]);
            *(LAS u32x4*)(xcb + (tk + tt) * 72 + 8 * cg8) = w;
        }
        if (c == 31 && tq >= 62) {
            float* o = a.out_() + O_PRC + ((size_t)(l * 4 + b) * 3) * DRNN + ch0 + 8 * cg8;
#pragma unroll
            for (int tt = 0; tt < 2; ++tt) { const int jx = tk + tt - 125;
                if (jx >= 0) { *(f32x4*)(o + (size_t)jx * DRNN) = (f32x4){xr[3 + tt][0], xr[3 + tt][1], xr[3 + tt][2], xr[3 + tt][3]}; *(f32x4*)(o + (size_t)jx * DRNN + 4) = (f32x4){xr[3 + tt][4], xr[3 + tt][5], xr[3 + tt][6], xr[3 + tt][7]}; } }
        }
    } else {
#pragma unroll 4
        for (int idx = tid; idx < 128 * 64; idx += 512) { const int bb = idx >> 6, ch = idx & 63;
            const float* stp = a.in_(I_SRC) + ((size_t)(l * 128 + bb) * 3) * DRNN + ch0 + ch;
            const float s0 = stp[0], s1 = stp[DRNN], s2 = stp[2 * DRNN], xn = UINS[(size_t)bb * 1792 + 768 + ch0 + ch];
            const float xc = cbias[ch] + s0 * cw[ch] + s1 * cw[DRNN + ch] + s2 * cw[2 * DRNN + ch] + xn * cw[3 * DRNN + ch];
            xcf[idx] = xc; xcb[bb * 72 + ch] = (bf16_t)f2bf(xc);
            float* o = a.out_() + O_SRC + ((size_t)(l * 128 + bb) * 3) * DRNN + ch0 + ch; o[0] = s1; o[DRNN] = s2; o[2 * DRNN] = xn; }
    }
    __syncthreads();
    {
        const int fr = lane & 15, q = lane >> 4, tok = wave * 16 + fr;
        const bf16x8 a0 = *(const LAS bf16x8*)(xcb + tok * 72 + 8 * q), a1 = *(const LAS bf16x8*)(xcb + tok * 72 + 32 + 8 * q);
        float* DA = (float*)(ws + WS_U); float* DB = DA + (size_t)MP * DRNN;
#pragma unroll
        for (int jt = 0; jt < 4; ++jt) {
            const LAS bf16_t* wp = WT + (jt * 16 + fr) * 72 + 8 * q;
            f32x4 gx = (f32x4){0.f, 0.f, 0.f, 0.f}, ga = gx;
            gx = mfma16(*(const LAS bf16x8*)(wp), a0, gx); gx = mfma16(*(const LAS bf16x8*)(wp + 32), a1, gx);
            ga = mfma16(*(const LAS bf16x8*)(wp + 64 * 72), a0, ga); ga = mfma16(*(const LAS bf16x8*)(wp + 64 * 72 + 32), a1, ga);
            f32x4 av4, bv4;
#pragma unroll
            for (int i = 0; i < 4; ++i) { const int ch = jt * 16 + 4 * q + i;
                const float sgx = sigmoidf_(gx[i] + cst[64 + ch]), sga = sigmoidf_(ga[i] + cst[128 + ch]);
                const float log_a = 8.0f * sga * cst[ch]; const float av = __expf(log_a);
                const float bxv = sqrtf(fmaxf(1.0f - av * av, 0.f)) * sgx * xcf[tok * 64 + ch];
                av4[i] = av; bv4[i] = bxv; }
            *(LAS f32x4*)(Aa + tok * 64 + jt * 16 + 4 * q) = av4; *(LAS f32x4*)(Bx + tok * 64 + jt * 16 + 4 * q) = bv4;
            if (!sample) { __builtin_nontemporal_store(av4, (f32x4*)(DA + (size_t)(row0 + tok) * DRNN + ch0 + jt * 16 + 4 * q)); __builtin_nontemporal_store(bv4, (f32x4*)(DB + (size_t)(row0 + tok) * DRNN + ch0 + jt * 16 + 4 * q)); }
        }
    }
    __syncthreads();
    if (sample) {
#pragma unroll 4
        for (int idx = tid; idx < 128 * 64; idx += 512) { const int bb = idx >> 6, ch = idx & 63;
            const float h0 = a.in_(I_SH)[(size_t)(l * 128 + bb) * DRNN + ch0 + ch];
            const float h = Aa[idx] * h0 + Bx[idx];
            const float gate = UINS[(size_t)bb * 1792 + ch0 + ch];
            ((bf16_t*)(ws + WS_MIX))[(size_t)(MP + bb) * DM + ch0 + ch] = (bf16_t)f2bf(h * gelu_tanh(gate));
            a.out_()[O_SH + (size_t)(l * 128 + bb) * DRNN + ch0 + ch] = h; }
    } else {
        const int ch = tid & 63, sg = tid >> 6;
        { float Ap = 1.f, Bp = 0.f;
#pragma unroll 4
          for (int t = sg * 16; t < sg * 16 + 16; ++t) { const float av = Aa[t * 64 + ch], bv = Bx[t * 64 + ch]; Bp = av * Bp + bv; Ap *= av; }
          seg[sg * 64 + ch] = Ap; seg[512 + sg * 64 + ch] = Bp; }
        __syncthreads();
        float* CA = (float*)(ws + WS_CARA); float* CB = (float*)(ws + WS_CARB);
        if (mode == 0) {
            if (sg == 0) { float A = 1.f, B = 0.f;
#pragma unroll
                for (int s = 0; s < 8; ++s) { const float sa = seg[s * 64 + ch]; B = sa * B + seg[512 + s * 64 + ch]; A *= sa; }
                CA[(size_t)(b * 32 + c) * DRNN + ch0 + ch] = A; CB[(size_t)(b * 32 + c) * DRNN + ch0 + ch] = B; }
        } else {
            if (tid < 64) { float h = 0.f; for (int cc = 0; cc < c; ++cc) h = CA[(size_t)(b * 32 + cc) * DRNN + ch0 + ch] * h + CB[(size_t)(b * 32 + cc) * DRNN + ch0 + ch]; hin[ch] = h; }
            __syncthreads();
            float h = hin[ch];
            for (int s = 0; s < sg; ++s) h = seg[s * 64 + ch] * h + seg[512 + s * 64 + ch];
            bf16_t* MIX = (bf16_t*)(ws + WS_MIX);
#pragma unroll 4
            for (int t = sg * 16; t < sg * 16 + 16; ++t) {
                h = Aa[t * 64 + ch] * h + Bx[t * 64 + ch];
                const float gate = bf2f(UIN[(size_t)(row0 + t) * 1792 + ch0 + ch]);
                MIX[(size_t)(row0 + t) * DM + ch0 + ch] = (bf16_t)f2bf(h * gelu_tanh(gate)); }
            if (c == 31 && sg == 7) a.out_()[O_PH + (size_t)(l * 4 + b) * DRNN + ch0 + ch] = h;
        }
    }
    __syncthreads();
}

__device__ __forceinline__ void rglru_scan_item2(const Args& a, LAS unsigned char* L, int l, int item0, const int tid) {
    unsigned char* ws = a.ws_();
    const int hfi = tid >> 8, t256 = tid & 255, cq = t256 & 15, sg = t256 >> 4;
    LAS f32x4* seg = (LAS f32x4*)L + hfi * 1024;
    LAS f32x4* par = seg + 512;
    const int item = item0 + hfi;
    const int n = item % 12, rest = item / 12, c = rest & 31, b = rest >> 5;
    const int ch0 = n * 64 + 4 * cq, row0 = b * SEQ + c * 128 + sg * 8;
    const float* DA = (const float*)(ws + WS_U); const float* DB = DA + (size_t)MP * DRNN;
    const float* CA = (const float*)(ws + WS_CARA); const float* CB = (const float*)(ws + WS_CARB);
    f32x4 av[8], bv[8];
#pragma unroll
    for (int t = 0; t < 8; ++t) { const size_t o = (size_t)(row0 + t) * DRNN + ch0; av[t] = __builtin_nontemporal_load((const f32x4*)(DA + o)); bv[t] = __builtin_nontemporal_load((const f32x4*)(DB + o)); }
    const f32x4 one = (f32x4){1.f, 1.f, 1.f, 1.f}, zero = (f32x4){0.f, 0.f, 0.f, 0.f};
    f32x4 pa = one, pb = zero;
#pragma unroll
    for (int k = 0; k < 2; ++k) { const int cc = sg * 2 + k; if (cc < c) { const size_t o = (size_t)(b * 32 + cc) * DRNN + ch0; const f32x4 xa = *(const f32x4*)(CA + o), xb = *(const f32x4*)(CB + o); pb = xa * pb + xb; pa *= xa; } }
    f32x4 Ap = one, Bp = zero;
#pragma unroll
    for (int t = 0; t < 8; ++t) { Bp = av[t] * Bp + bv[t]; Ap *= av[t]; }
    seg[sg * 16 + cq] = Ap; seg[256 + sg * 16 + cq] = Bp; par[sg * 16 + cq] = pa; par[256 + sg * 16 + cq] = pb;
    __syncthreads();
    f32x4 h = zero;
#pragma unroll
    for (int s = 0; s < 16; ++s) h = par[s * 16 + cq] * h + par[256 + s * 16 + cq];
    for (int s = 0; s < sg; ++s) h = seg[s * 16 + cq] * h + seg[256 + s * 16 + cq];
    const bf16_t* UIN = (const bf16_t*)(ws + WS_UIN); bf16_t* MIX = (bf16_t*)(ws + WS_MIX);
#pragma unroll
    for (int t = 0; t < 8; ++t) {
        h = av[t] * h + bv[t];
        const size_t r = (size_t)(row0 + t);
        const u32x2 gw2 = __builtin_nontemporal_load((const u32x2*)(UIN + r * 1792 + ch0));
        u32x2 w; w.x = pk2(h[0] * gelu_tanh(bflo(gw2.x)), h[1] * gelu_tanh(bfhi(gw2.x))); w.y = pk2(h[2] * gelu_tanh(bflo(gw2.y)), h[3] * gelu_tanh(bfhi(gw2.y)));
        *(u32x2*)(MIX + r * DM + ch0) = w; }
    if (c == 31 && sg == 15) *(f32x4*)(a.out_() + O_PH + (size_t)(l * 4 + b) * DRNN + ch0) = h;
    __syncthreads();
}

template <int NT, bool SWA>
__device__ __forceinline__ void attn_core(const LAS bf16_t* Ks, const LAS bf16_t* Vt, int VS, bf16x8 q0, bf16x8 q1, int tile0, int qi, bool first_block, float sink,
                                          f32x4 (&o)[4], float& den, int fr, int q) {
    f32x4 s[NT];
#pragma unroll
    for (int j = 0; j < NT; ++j) {
        const LAS bf16_t* kp = Ks + ((tile0 + j) * 16 + fr) * 72 + 8 * q;
        f32x4 z = (f32x4){0.f, 0.f, 0.f, 0.f};
        z = mfma16(*(const LAS bf16x8*)kp, q0, z); z = mfma16(*(const LAS bf16x8*)(kp + 32), q1, z);
        s[j] = z;
        if (j & 1) asm volatile("" ::: "memory");
    }
    float mx = -1e30f;
    const int lo = (first_block && qi < 128) ? 128 : qi, hi = qi + 128;
#pragma unroll
    for (int j = 0; j < NT; ++j)
#pragma unroll
        for (int i = 0; i < 4; ++i) {
            if (SWA) { const int jj = (tile0 + j) * 16 + 4 * q + i; if (jj < lo || jj > hi) s[j][i] = -1e30f; }
            mx = fmaxf(mx, s[j][i]);
        }
    mx = fmaxf(mx, __shfl_xor(mx, 16)); mx = fmaxf(mx, __shfl_xor(mx, 32));
    if (SWA) mx = fmaxf(mx, sink);
    float sum = 0.f;
#pragma unroll
    for (int j = 0; j < NT; ++j)
#pragma unroll
        for (int i = 0; i < 4; ++i) { const float p = __expf(s[j][i] - mx); s[j][i] = p; sum += p; }
    sum += __shfl_xor(sum, 16); sum += __shfl_xor(sum, 32);
    if (SWA) sum += __expf(sink - mx);
    den = sum;
#pragma unroll
    for (int db = 0; db < 4; ++db) o[db] = (f32x4){0.f, 0.f, 0.f, 0.f};
#pragma unroll
    for (int t = 0; t < NT / 2; ++t) {
        u32x4 pw; pw.x = pk2(s[2 * t][0], s[2 * t][1]); pw.y = pk2(s[2 * t][2], s[2 * t][3]); pw.z = pk2(s[2 * t + 1][0], s[2 * t + 1][1]); pw.w = pk2(s[2 * t + 1][2], s[2 * t + 1][3]);
        const bf16x8 pf = __builtin_bit_cast(bf16x8, pw);
#pragma unroll
        for (int db = 0; db < 4; ++db) {
            const LAS bf16_t* vp = Vt + (db * 16 + fr) * VS + (tile0 + 2 * t) * 16 + 4 * q;
            const u32x2 v0 = *(const LAS u32x2*)vp, v1 = *(const LAS u32x2*)(vp + 16);
            u32x4 vw; vw.x = v0.x; vw.y = v0.y; vw.z = v1.x; vw.w = v1.y;
            o[db] = mfma16(__builtin_bit_cast(bf16x8, vw), pf, o[db]);
        }
        asm volatile("" ::: "memory");
    }
}
__device__ __forceinline__ void store_attn_out(bf16_t* dst, const f32x4 (&o)[4], float den, int q) {
    const float inv = 1.0f / den;
#pragma unroll
    for (int db = 0; db < 4; ++db) { u32x2 w; w.x = pk2(o[db][0] * inv, o[db][1] * inv); w.y = pk2(o[db][2] * inv, o[db][3] * inv); *(u32x2*)(dst + db * 16 + 4 * q) = w; }
}

__device__ __forceinline__ void memattn_prompt_item(const Args& a, LAS unsigned char* L, int l, int item, const int tid) {
    const int lane = tid & 63, wave = tid >> 6, fr = lane & 15, q = lane >> 4;
    unsigned char* ws = a.ws_();
    const int tp = item & 15, bh = item >> 4, h = bh & 3, b = bh >> 2;
    LAS bf16_t* Ks = (LAS bf16_t*)L; LAS bf16_t* Vt = (LAS bf16_t*)(L + 36864);
    const bf16_t* mk = (const bf16_t*)(ws + WS_MK) + (size_t)((l * 4 + b) * 4 + h) * 256 * 64;
    const bf16_t* mv = (const bf16_t*)(ws + WS_MVT) + (size_t)((l * 4 + b) * 4 + h) * 64 * 256;
#pragma unroll
    for (int i = 0; i < 4; ++i) { const int idx = tid + 512 * i;
        { const int row = idx >> 3, cc = idx & 7; *(LAS u32x4*)(Ks + row * 72 + cc * 8) = *(const u32x4*)(mk + row * 64 + cc * 8); }
        { const int row = idx >> 5, cc = idx & 31; *(LAS u32x4*)(Vt + row * 264 + cc * 8) = *(const u32x4*)(mv + row * 256 + cc * 8); } }
    __syncthreads();
    const int ld = (l < 2) ? 1792 : 1536, qoff = (l < 2) ? 1536 : 768;
#pragma unroll 1
    for (int tt = 0; tt < 2; ++tt) {
    const int tile = 2 * tp + tt;
    const int row = b * SEQ + tile * 128 + wave * 16 + fr;
    const bf16_t* qp = (const bf16_t*)(ws + WS_UIN) + (size_t)row * ld + qoff + h * 64 + 8 * q;
    float x1[8], x2[8]; unpack8(__builtin_nontemporal_load((const u32x4*)qp), x1); unpack8(__builtin_nontemporal_load((const u32x4*)(qp + 32)), x2);
    float ss = 0.f;
#pragma unroll
    for (int e = 0; e < 8; ++e) ss += x1[e] * x1[e] + x2[e] * x2[e];
    ss += __shfl_xor(ss, 16); ss += __shfl_xor(ss, 32);
    const float r = 0.125f / sqrtf(ss * (1.0f / 64.0f) + 1e-6f);
    const float* g = a.in_(I_MQNG) + l * 64 + 8 * q;
    u32x4 w0, w1;
    w0.x = pk2(x1[0] * r * g[0], x1[1] * r * g[1]); w0.y = pk2(x1[2] * r * g[2], x1[3] * r * g[3]); w0.z = pk2(x1[4] * r * g[4], x1[5] * r * g[5]); w0.w = pk2(x1[6] * r * g[6], x1[7] * r * g[7]);
    w1.x = pk2(x2[0] * r * g[32], x2[1] * r * g[33]); w1.y = pk2(x2[2] * r * g[34], x2[3] * r * g[35]); w1.z = pk2(x2[4] * r * g[36], x2[5] * r * g[37]); w1.w = pk2(x2[6] * r * g[38], x2[7] * r * g[39]);
    f32x4 o[4]; float den;
    attn_core<16, false>(Ks, Vt, 264, __builtin_bit_cast(bf16x8, w0), __builtin_bit_cast(bf16x8, w1), 0, 0, false, 0.f, o, den, fr, q);
    store_attn_out((bf16_t*)(ws + WS_MIX) + (size_t)row * DM + 768 + h * 64, o, den, q);
    }
    __syncthreads();
}

__device__ __forceinline__ void swa_prompt_item(const Args& a, LAS unsigned char* L, int j, int item, bool write_state, const int tid) {
    const int lane = tid & 63, wave = __builtin_amdgcn_readfirstlane(tid >> 6), fr = lane & 15, q = lane >> 4;
    unsigned char* ws = a.ws_();
    const int kvh = item & 3, qb = (item >> 2) & 31, b = item >> 7;
    LAS bf16_t* Ks = (LAS bf16_t*)L; LAS bf16_t* Vt = (LAS bf16_t*)(L + 36864);
    const bf16_t* UIN = (const bf16_t*)(ws + WS_UIN);
    const float* rc = (const float*)(ws + WS_ROPEC); const float* rs = (const float*)(ws + WS_ROPES);
    const bool wst = write_state && qb == 31;
    const int tokq = qb * 128 + wave * 16 + fr, row = b * SEQ + tokq;
    float qc[8], qs[8];
    { const f32x4 c0 = *(const f32x4*)(rc + tokq * 32 + 8 * q), c1 = *(const f32x4*)(rc + tokq * 32 + 8 * q + 4), s0 = *(const f32x4*)(rs + tokq * 32 + 8 * q), s1 = *(const f32x4*)(rs + tokq * 32 + 8 * q + 4);
#pragma unroll
      for (int e2 = 0; e2 < 4; ++e2) { qc[e2] = c0[e2]; qc[4 + e2] = c1[e2]; qs[e2] = s0[e2]; qs[4 + e2] = s1[e2]; } }
    u32x4 qraw[3][2];
#pragma unroll
    for (int g = 0; g < 3; ++g) { const bf16_t* qp = UIN + (size_t)row * 1536 + (kvh * 3 + g) * 64 + 8 * q; qraw[g][0] = __builtin_nontemporal_load((const u32x4*)qp); qraw[g][1] = __builtin_nontemporal_load((const u32x4*)(qp + 32)); }
#pragma unroll
    for (int rep = 0; rep < 2; ++rep) {
        const int task = tid + 512 * rep, jj = task >> 2, dg = task & 3, tok = qb * 128 - 128 + jj;
        float x1[8], x2[8];
        if (tok >= 0) { const bf16_t* kp = UIN + (size_t)(b * SEQ + tok) * 1536 + 1024 + kvh * 64 + 8 * dg; unpack8(*(const u32x4*)kp, x1); unpack8(*(const u32x4*)(kp + 32), x2); }
        else {
#pragma unroll
            for (int e = 0; e < 8; ++e) { x1[e] = 0.f; x2[e] = 0.f; } }
        float ss = 0.f;
#pragma unroll
        for (int e = 0; e < 8; ++e) ss += x1[e] * x1[e] + x2[e] * x2[e];
        ss += __shfl_xor(ss, 1); ss += __shfl_xor(ss, 2);
        const float r = 1.0f / sqrtf(ss * (1.0f / 64.0f) + 1e-6f);
        const float* kg = a.in_(I_KNG) + 8 * dg; const int tp = tok >= 0 ? tok : 0;
        float o1[8], o2[8];
#pragma unroll
        for (int e = 0; e < 8; ++e) { const float c = rc[tp * 32 + 8 * dg + e], s = rs[tp * 32 + 8 * dg + e]; const float y1 = x1[e] * r * kg[e], y2 = x2[e] * r * kg[32 + e];
            o1[e] = y1 * c - y2 * s; o2[e] = y2 * c + y1 * s; }
        u32x4 w; w.x = pk2(o1[0], o1[1]); w.y = pk2(o1[2], o1[3]); w.z = pk2(o1[4], o1[5]); w.w = pk2(o1[6], o1[7]); *(LAS u32x4*)(Ks + jj * 72 + 8 * dg) = w;
        w.x = pk2(o2[0], o2[1]); w.y = pk2(o2[2], o2[3]); w.z = pk2(o2[4], o2[5]); w.w = pk2(o2[6], o2[7]); *(LAS u32x4*)(Ks + jj * 72 + 32 + 8 * dg) = w;
        if (wst && jj >= 128) { float* o = a.out_() + O_PK + ((size_t)(b * 128 + jj - 128) * 4 + kvh) * 64 + 8 * dg;
            *(f32x4*)o = (f32x4){o1[0], o1[1], o1[2], o1[3]}; *(f32x4*)(o + 4) = (f32x4){o1[4], o1[5], o1[6], o1[7]};
            *(f32x4*)(o + 32) = (f32x4){o2[0], o2[1], o2[2], o2[3]}; *(f32x4*)(o + 36) = (f32x4){o2[4], o2[5], o2[6], o2[7]}; }
    }
    {
        const int jj = tid & 255, hf = tid >> 8, tok = qb * 128 - 128 + jj;
#pragma unroll
        for (int c8 = 0; c8 < 4; ++c8) {
            float v[8];
            if (tok >= 0) unpack8(*(const u32x4*)(UIN + (size_t)(b * SEQ + tok) * 1536 + 1280 + kvh * 64 + hf * 32 + c8 * 8), v);
            else {
#pragma unroll
                for (int e = 0; e < 8; ++e) v[e] = 0.f; }
#pragma unroll
            for (int e = 0; e < 8; ++e) Vt[(hf * 32 + c8 * 8 + e) * 264 + jj] = (bf16_t)f2bf(v[e]);
            if (wst && jj >= 128) { float* o = a.out_() + O_PV + ((size_t)(b * 128 + jj - 128) * 4 + kvh) * 64 + hf * 32 + c8 * 8;
                *(f32x4*)o = (f32x4){v[0], v[1], v[2], v[3]}; *(f32x4*)(o + 4) = (f32x4){v[4], v[5], v[6], v[7]}; }
        }
    }
    __syncthreads();
#pragma unroll
    for (int g = 0; g < 3; ++g) {
        const int hq = kvh * 3 + g;
        float x1[8], x2[8]; unpack8(qraw[g][0], x1); unpack8(qraw[g][1], x2);
        float ss = 0.f;
#pragma unroll
        for (int e = 0; e < 8; ++e) ss += x1[e] * x1[e] + x2[e] * x2[e];
        ss += __shfl_xor(ss, 16); ss += __shfl_xor(ss, 32);
        const float r = 1.0f / sqrtf(ss * (1.0f / 64.0f) + 1e-6f);
        const float* qg = a.in_(I_QNG) + j * 64 + 8 * q;
        float o1[8], o2[8];
#pragma unroll
        for (int e = 0; e < 8; ++e) { const float c = qc[e], s = qs[e]; const float y1 = x1[e] * r * qg[e], y2 = x2[e] * r * qg[32 + e];
            o1[e] = (y1 * c - y2 * s) * 0.125f; o2[e] = (y2 * c + y1 * s) * 0.125f; }
        u32x4 w0, w1;
        w0.x = pk2(o1[0], o1[1]); w0.y = pk2(o1[2], o1[3]); w0.z = pk2(o1[4], o1[5]); w0.w = pk2(o1[6], o1[7]);
        w1.x = pk2(o2[0], o2[1]); w1.y = pk2(o2[2], o2[3]); w1.z = pk2(o2[4], o2[5]); w1.w = pk2(o2[6], o2[7]);
        f32x4 o[4]; float den; const float sinkv = a.in_(I_SINK)[j * 12 + hq];
        attn_core<10, true>(Ks, Vt, 264, __builtin_bit_cast(bf16x8, w0), __builtin_bit_cast(bf16x8, w1), wave & ~1, wave * 16 + fr, qb == 0, sinkv, o, den, fr, q);
        store_attn_out((bf16_t*)(ws + WS_MIX) + (size_t)row * DM + hq * 64, o, den, q);
    }
    __syncthreads();
}

__device__ __forceinline__ void sample_attn_item(const Args& a, LAS unsigned char* L, int b, int NH, int G, int NC, const float* Kc, const float* Vc,
                                                 int qcol, const float* qg, bool swa, int j, bool write_state, int mixoff, const int tid) {
    const int lane = tid & 63, wave = tid >> 6;
    unsigned char* ws = a.ws_();
    LAS float* qs = (LAS float*)L;
    LAS float* sc = qs + 768;
    LAS float* knew = sc + 12 * 260;
    LAS float* vnew = knew + 256;
    LAS float* part = vnew + 256;
    const float* U = (const float*)(ws + WS_UINS) + (size_t)b * 1792;
    const float* rc = (const float*)(ws + WS_ROPEC) + 4096 * 32; const float* rs = (const float*)(ws + WS_ROPES) + 4096 * 32;
    for (int h = wave; h < NH; h += 8) {
        const float x = U[qcol + h * 64 + lane];
        const float ss = wave_sum(x * x); const float r = 1.0f / sqrtf(ss * (1.0f / 64.0f) + 1e-6f);
        float y = x * r * qg[lane];
        if (swa) { const float p = __shfl_xor(y, 32); const float c = rc[lane & 31], s = rs[lane & 31]; y = (lane < 32) ? (y * c - p * s) : (y * c + p * s); }
        qs[h * 64 + lane] = y * 0.125f;
    }
    if (swa && wave < 4) {
        const float x = U[1024 + wave * 64 + lane];
        const float ss = wave_sum(x * x); const float r = 1.0f / sqrtf(ss * (1.0f / 64.0f) + 1e-6f);
        float y = x * r * a.in_(I_KNG)[lane];
        const float p = __shfl_xor(y, 32); const float c = rc[lane & 31], s = rs[lane & 31]; y = (lane < 32) ? (y * c - p * s) : (y * c + p * s);
        const float v = U[1280 + wave * 64 + lane];
        knew[wave * 64 + lane] = y; vnew[wave * 64 + lane] = v;
        if (write_state) { a.out_()[O_SK + (size_t)b * 256 + wave * 64 + lane] = y; a.out_()[O_SV + (size_t)b * 256 + wave * 64 + lane] = v; }
    }
    __syncthreads();
    {
        const int kvh = lane >> 4, sub = lane & 15;
#pragma unroll 8
        for (int m = wave; m < NC; m += 8) {
            const f32x4 kv = __builtin_nontemporal_load((const f32x4*)(Kc + ((size_t)m * 4 + kvh) * 64 + 4 * sub));
#pragma unroll
            for (int g = 0; g < 3; ++g) if (g < G) {
                const int h = kvh * G + g; const f32x4 qv = *(const LAS f32x4*)(qs + h * 64 + 4 * sub);
                float d = (kv[0] * qv[0] + kv[1] * qv[1]) + (kv[2] * qv[2] + kv[3] * qv[3]);
                d += __shfl_xor(d, 1); d += __shfl_xor(d, 2); d += __shfl_xor(d, 4); d += __shfl_xor(d, 8);
                if (sub == 0) sc[h * 260 + m] = d;
            }
        }
        if (swa && wave == 0) {
            const f32x4 kv = *(const LAS f32x4*)(knew + kvh * 64 + 4 * sub);
#pragma unroll
            for (int g = 0; g < 3; ++g) {
                const int h = kvh * 3 + g; const f32x4 qv = *(const LAS f32x4*)(qs + h * 64 + 4 * sub);
                float d = (kv[0] * qv[0] + kv[1] * qv[1]) + (kv[2] * qv[2] + kv[3] * qv[3]);
                d += __shfl_xor(d, 1); d += __shfl_xor(d, 2); d += __shfl_xor(d, 4); d += __shfl_xor(d, 8);
                if (sub == 0) sc[h * 260 + NC] = d;
            }
        }
    }
    __syncthreads();
    const int NK = NC + (swa ? 1 : 0);
    for (int h = wave; h < NH; h += 8) {
        float mx = -1e30f;
        for (int m = lane; m < NK; m += 64) mx = fmaxf(mx, sc[h * 260 + m]);
        mx = wave_max(mx);
        float sk = 0.f; if (swa) { sk = a.in_(I_SINK)[j * 12 + h]; mx = fmaxf(mx, sk); }
        float sum = 0.f;
        for (int m = lane; m < NK; m += 64) { const float p = __expf(sc[h * 260 + m] - mx); sc[h * 260 + m] = p; sum += p; }
        sum = wave_sum(sum); if (swa) sum += __expf(sk - mx);
        const float inv = 1.0f / sum;
        for (int m = lane; m < NK; m += 64) sc[h * 260 + m] *= inv;
    }
    __syncthreads();
    {
        const int kvh = wave & 3, hf = wave >> 2, m0 = hf * (NC / 2), m1 = m0 + NC / 2, sub = lane & 15, ks = lane >> 4;
        f32x4 acc[3] = { (f32x4){0.f, 0.f, 0.f, 0.f}, (f32x4){0.f, 0.f, 0.f, 0.f}, (f32x4){0.f, 0.f, 0.f, 0.f} };
#pragma unroll 4
        for (int m = m0 + ks; m < m1; m += 4) { const f32x4 v = __builtin_nontemporal_load((const f32x4*)(Vc + ((size_t)m * 4 + kvh) * 64 + 4 * sub));
#pragma unroll
            for (int g = 0; g < 3; ++g) if (g < G) acc[g] += v * sc[(kvh * G + g) * 260 + m]; }
#pragma unroll
        for (int g = 0; g < 3; ++g) if (g < G) {
            f32x4 r = acc[g];
#pragma unroll
            for (int i = 0; i < 4; ++i) { r[i] += __shfl_xor(r[i], 16); r[i] += __shfl_xor(r[i], 32); }
            if (ks == 0) *(LAS f32x4*)(part + (hf * 12 + kvh * G + g) * 64 + 4 * sub) = r; }
    }
    __syncthreads();
    for (int idx = tid; idx < NH * 64; idx += 512) { const int h = idx >> 6, d = idx & 63;
        float o = part[h * 64 + d] + part[(12 + h) * 64 + d];
        if (swa) o += sc[h * 260 + NC] * vnew[(h / 3) * 64 + d];
        ((bf16_t*)(ws + WS_MIX))[(size_t)(MP + b) * DM + mixoff + idx] = (bf16_t)f2bf(o); }
    __syncthreads();
}

__device__ __forceinline__ void ffn_ew_item(const Args& a, int l, int item, const int tid) {
    unsigned char* ws = a.ws_();
    const int run = item / 3, third = item % 3, cgp = tid & 127, sub = tid >> 7;
    const int gt0 = run * 64 + sub * 16, b = gt0 >> 12, tin = gt0 & 4095, c0 = third * 1024 + cgp * 8;
    const bf16_t* U = (const bf16_t*)(ws + WS_U); bf16_t* G = (bf16_t*)(ws + WS_G);
    const float* cw = a.in_(I_FCW) + (size_t)l * 3 * 6144; const float* cb = a.in_(I_FCB) + (size_t)l * 6144;
    float w[2][3][8], bias[2][8];
#pragma unroll
    for (int hf = 0; hf < 2; ++hf) {
#pragma unroll
        for (int jx = 0; jx < 3; ++jx) { const f32x4 p0 = *(const f32x4*)(cw + jx * 6144 + hf * DFF + c0), p1 = *(const f32x4*)(cw + jx * 6144 + hf * DFF + c0 + 4);
#pragma unroll
            for (int e = 0; e < 4; ++e) { w[hf][jx][e] = p0[e]; w[hf][jx][4 + e] = p1[e]; } }
        const f32x4 p0 = *(const f32x4*)(cb + hf * DFF + c0), p1 = *(const f32x4*)(cb + hf * DFF + c0 + 4);
#pragma unroll
        for (int e = 0; e < 4; ++e) { bias[hf][e] = p0[e]; bias[hf][4 + e] = p1[e]; }
    }
    float p2[2][8], p1v[2][8];
#pragma unroll
    for (int hf = 0; hf < 2; ++hf) {
        if (tin != 0) { unpack8(*(const u32x4*)(U + (size_t)(gt0 - 2) * 6144 + hf * DFF + c0), p2[hf]); unpack8(*(const u32x4*)(U + (size_t)(gt0 - 1) * 6144 + hf * DFF + c0), p1v[hf]); }
        else {
#pragma unroll
            for (int e = 0; e < 8; ++e) { p2[hf][e] = 0.f; p1v[hf][e] = 0.f; } }
    }
#pragma unroll 2
    for (int t = 0; t < 16; ++t) {
        float cur[2][8], v[2][8];
#pragma unroll
        for (int hf = 0; hf < 2; ++hf) { unpack8(*(const u32x4*)(U + (size_t)(gt0 + t) * 6144 + hf * DFF + c0), cur[hf]);
#pragma unroll
            for (int e = 0; e < 8; ++e) { v[hf][e] = bias[hf][e] + p2[hf][e] * w[hf][0][e] + p1v[hf][e] * w[hf][1][e] + cur[hf][e] * w[hf][2][e]; p2[hf][e] = p1v[hf][e]; p1v[hf][e] = cur[hf][e]; } }
        u32x4 o; o.x = pk2(gelu_tanh(v[0][0]) * v[1][0], gelu_tanh(v[0][1]) * v[1][1]); o.y = pk2(gelu_tanh(v[0][2]) * v[1][2], gelu_tanh(v[0][3]) * v[1][3]);
        o.z = pk2(gelu_tanh(v[0][4]) * v[1][4], gelu_tanh(v[0][5]) * v[1][5]); o.w = pk2(gelu_tanh(v[0][6]) * v[1][6], gelu_tanh(v[0][7]) * v[1][7]);
        *(u32x4*)(G + (size_t)(gt0 + t) * DFF + c0) = o;
        if (tin + t >= 4094) { const int jx = tin + t - 4094;
#pragma unroll
            for (int hf = 0; hf < 2; ++hf) { float* op = a.out_() + O_PFC + ((size_t)(l * 4 + b) * 2 + jx) * 6144 + hf * DFF + c0;
                *(f32x4*)op = (f32x4){cur[hf][0], cur[hf][1], cur[hf][2], cur[hf][3]}; *(f32x4*)(op + 4) = (f32x4){cur[hf][4], cur[hf][5], cur[hf][6], cur[hf][7]}; } }
    }
}

__device__ __forceinline__ void ffn_fixup(const Args& a, int l, int pm, const int tid) {
    unsigned char* ws = a.ws_();
    const float* hb = (const float*)(ws + WS_HB); bf16_t* Gb = (bf16_t*)(ws + WS_G);
    const float* cw = a.in_(I_FCW) + (size_t)l * 3 * 6144; const float* cb = a.in_(I_FCB) + (size_t)l * 6144;
    for (int cgp = tid; cgp < 768; cgp += 512) {
        const int cc = cgp * 4;
        f32x4 w0[2], w1[2], w2[2], bb[2];
#pragma unroll
        for (int hf = 0; hf < 2; ++hf) { const int col = hf * 3072 + cc; w0[hf] = *(const f32x4*)(cw + col); w1[hf] = *(const f32x4*)(cw + 6144 + col); w2[hf] = *(const f32x4*)(cw + 2 * 6144 + col); bb[hf] = *(const f32x4*)(cb + col); }
        f32x4 l0[4][2], l1[4][2], f0[4][2], f1[4][2];
#pragma unroll
        for (int kq = 0; kq < 4; ++kq) {
            const int grp = pm * 4 + kq; const bool seq0 = (grp & 63) == 0;
#pragma unroll
            for (int hf = 0; hf < 2; ++hf) { const int col = hf * 3072 + cc; const f32x4 z = (f32x4){0.f, 0.f, 0.f, 0.f};
                const float* hp = hb + ((size_t)(grp - 1) * 4) * 6144 + col; const float* hc = hb + ((size_t)grp * 4) * 6144 + col;
                l0[kq][hf] = seq0 ? z : *(const f32x4*)(hp + 2 * 6144); l1[kq][hf] = seq0 ? z : *(const f32x4*)(hp + 3 * 6144); f0[kq][hf] = *(const f32x4*)(hc); f1[kq][hf] = *(const f32x4*)(hc + 6144); }
        }
#pragma unroll
        for (int kq = 0; kq < 4; ++kq) {
            const int grp = pm * 4 + kq;
            f32x4 va[2], vb[2];
#pragma unroll
            for (int hf = 0; hf < 2; ++hf) { va[hf] = bb[hf] + l0[kq][hf] * w0[hf] + l1[kq][hf] * w1[hf] + f0[kq][hf] * w2[hf]; vb[hf] = bb[hf] + l1[kq][hf] * w0[hf] + f0[kq][hf] * w1[hf] + f1[kq][hf] * w2[hf]; }
            u32x2 w; w.x = pk2(gelu_tanh(va[0][0]) * va[1][0], gelu_tanh(va[0][1]) * va[1][1]); w.y = pk2(gelu_tanh(va[0][2]) * va[1][2], gelu_tanh(va[0][3]) * va[1][3]);
            *(u32x2*)(Gb + (size_t)(grp * 64) * DFF + cc) = w;
            w.x = pk2(gelu_tanh(vb[0][0]) * vb[1][0], gelu_tanh(vb[0][1]) * vb[1][1]); w.y = pk2(gelu_tanh(vb[0][2]) * vb[1][2], gelu_tanh(vb[0][3]) * vb[1][3]);
            *(u32x2*)(Gb + (size_t)(grp * 64 + 1) * DFF + cc) = w;
        }
    }
    asm volatile("s_waitcnt vmcnt(0)" ::: "memory");
    __syncthreads();
}

#define XB_TMO      128
#define XB_XCNT(j)  (256  + 64 * (j))
#define XB_XSUB(j)  (1280 + 64 * (j))
#define XB_XGEN(j)  (2304 + 64 * (j))
#define XB_TOP      3328
#define XB_TOPGEN   3392
#define XCD_BAR_WORDS 3456
#define XB_SPIN_CAP (1u << 18)

__device__ __forceinline__ unsigned xb_ld(unsigned* p)              { return __hip_atomic_load(p, __ATOMIC_RELAXED, __HIP_MEMORY_SCOPE_AGENT); }
__device__ __forceinline__ unsigned xb_add(unsigned* p, unsigned v) { return __hip_atomic_fetch_add(p, v, __ATOMIC_RELAXED, __HIP_MEMORY_SCOPE_AGENT); }
__device__ __forceinline__ unsigned xb_xcc_id() { return (unsigned)__builtin_amdgcn_s_getreg((3 << 11) | 20) & 0xFu; }
#define XB_SPIN(cond, bar) do { unsigned _sp = 0; while (cond) { __builtin_amdgcn_s_sleep(1); \
    if ((++_sp & 255u) == 0u) { if (xb_ld(&(bar)[XB_TMO])) break; if (_sp > XB_SPIN_CAP) { atomicAdd(&(bar)[XB_TMO], 1u); break; } } } } while (0)

struct XcdBarrier {
    unsigned* bar; unsigned x;
    volatile LAS unsigned* st; bool t0;
};

__device__ __forceinline__ XcdBarrier xcd_barrier_post(unsigned* bar, volatile LAS unsigned* st, bool t0) {
    XcdBarrier b; b.bar = bar; b.x = xb_xcc_id(); b.st = st; b.t0 = t0;
    if (t0) (void)xb_add(&bar[XB_XCNT(b.x)], 1u);
    return b;
}
__device__ __forceinline__ void xcd_barrier_complete(unsigned* bar, unsigned x, unsigned& nloc, unsigned& nx) {
    const unsigned G = gridDim.x * gridDim.y * gridDim.z;
    unsigned sum, cnt, mine, sp = 0u;
    for (;;) {
        sum = 0u; cnt = 0u; mine = 0u;
#pragma unroll
        for (unsigned j = 0; j < 16; ++j) { const unsigned c = xb_ld(&bar[XB_XCNT(j)]); sum += c; cnt += (c > 0u) ? 1u : 0u; mine = (j == x) ? c : mine; }
        if (sum == G) break;
        __builtin_amdgcn_s_sleep(1);
        if ((++sp & 255u) == 0u) { if (xb_ld(&bar[XB_TMO])) break; if (sp > XB_SPIN_CAP) { atomicAdd(&bar[XB_TMO], 1u); break; } }
    }
    nloc = mine > 0u ? mine : 1u; nx = cnt > 0u ? cnt : 1u;
}

__device__ __forceinline__ void xcd_barrier(const XcdBarrier& b) {
    asm volatile("s_waitcnt vmcnt(0)" ::: "memory");
    __syncthreads();
    if (b.t0) {
        unsigned* bar = b.bar;
        __builtin_amdgcn_s_waitcnt(0);
        unsigned nloc = b.st[0], nx = b.st[1];
        if (nloc == 0u) { xcd_barrier_complete(bar, b.x, nloc, nx); b.st[0] = nloc; b.st[1] = nx; }
        const unsigned old = xb_add(&bar[XB_XSUB(b.x)], 1u);
        const unsigned gen = old / nloc;
        if (old + 1u == (gen + 1u) * nloc) {
            __builtin_amdgcn_fence(__ATOMIC_RELEASE, "agent");
            asm volatile("s_waitcnt vmcnt(0)" ::: "memory");
            const unsigned og = xb_add(&bar[XB_TOP], 1u);
            const unsigned tg = og / nx;
            if (og + 1u == (tg + 1u) * nx) xb_add(&bar[XB_TOPGEN], 1u);
            else XB_SPIN(xb_ld(&bar[XB_TOPGEN]) == tg, bar);
            __builtin_amdgcn_fence(__ATOMIC_ACQUIRE, "agent");
            xb_add(&bar[XB_XGEN(b.x)], 1u);
            asm volatile("s_waitcnt vmcnt(0)" ::: "memory");
        } else {
            XB_SPIN(xb_ld(&bar[XB_XGEN(b.x)]) == gen, bar);
            __builtin_amdgcn_fence(__ATOMIC_ACQUIRE, "agent");
            asm volatile("s_waitcnt vmcnt(0)" ::: "memory");
        }
    }
    __syncthreads();
}


__device__ __forceinline__ void grid_bar(unsigned* ctr, unsigned& epoch, int G, int tid) {
    asm volatile("s_waitcnt vmcnt(0) lgkmcnt(0)" ::: "memory");
    __syncthreads();
    epoch += 1u;
    if (tid == 0) {
        __builtin_amdgcn_fence(__ATOMIC_RELEASE, "agent");
        asm volatile("s_waitcnt vmcnt(0)" ::: "memory");
        __hip_atomic_fetch_add(ctr, 1u, __ATOMIC_RELAXED, __HIP_MEMORY_SCOPE_AGENT);
        const unsigned want = epoch * (unsigned)G; unsigned spins = 0;
        while (__hip_atomic_load(ctr, __ATOMIC_RELAXED, __HIP_MEMORY_SCOPE_AGENT) < want) { __builtin_amdgcn_s_sleep(1); if (++spins > (1u << 24)) break; }
        __builtin_amdgcn_fence(__ATOMIC_ACQUIRE, "agent");
        asm volatile("s_waitcnt vmcnt(0)" ::: "memory");
    }
    __syncthreads();
}

constexpr int NPHASES = 23;
enum { K_PRO = 0, K_INPROJ, K_RA, K_RB, K_ATT, K_OUT, K_UP, K_EW, K_DOWN };

__global__ void __launch_bounds__(NTHREADS, 2) fwd_kernel(KArgs ka) {
    extern __shared__ __attribute__((aligned(16))) unsigned char lds_raw[];
    LAS unsigned char* L = (LAS unsigned char*)lds_raw;
    const int tid_e = threadIdx.x; const int wv_s = __builtin_amdgcn_readfirstlane(tid_e >> 6);
#define TID_NOW() (wv_s * 64 + (int)__builtin_amdgcn_mbcnt_hi(~0u, __builtin_amdgcn_mbcnt_lo(~0u, 0u)))
    {
        LAS unsigned long long* tab = (LAS unsigned long long*)(L + ARGTAB_OFF);
        if (tid_e == 0) {
#pragma unroll
            for (int i = 0; i < 35; ++i) tab[i] = (unsigned long long)ka.in[i];
            tab[35] = (unsigned long long)ka.out; tab[36] = (unsigned long long)ka.ws;
            ((LAS unsigned*)(L + ARGTAB_OFF + 320))[0] = 0u; ((LAS unsigned*)(L + ARGTAB_OFF + 320))[1] = 0u;
        }
        __syncthreads();
    }
    (void)xcd_barrier_post((unsigned*)(ka.ws + WS_CTL), (volatile LAS unsigned*)(L + ARGTAB_OFF + 320), tid_e == 0);
    Args a; a.t = (LAS const unsigned*)(L + ARGTAB_OFF);
    const int ph_lo = ka.ph_lo, ph_hi = ka.ph_hi;
    if (ph_lo == 0) {
        const int tid0 = tid_e, lane0 = tid0 & 63, wave0 = __builtin_amdgcn_readfirstlane(tid0 >> 6), G0 = gridDim.x;
        prologue(a, L, wave0 * G0 + (int)blockIdx.x, G0 * NWAVES, wave0, lane0);
    }
    for (int ph = (ph_lo > 1 ? ph_lo : 1); ph < ph_hi; ++ph) {
        if (ph > ph_lo) {
            if (ph_hi > 1000) cg::this_grid().sync();
            { XcdBarrier xb_; xb_.bar = (unsigned*)(a.ws_() + WS_CTL); xb_.x = xb_xcc_id(); xb_.st = (volatile LAS unsigned*)(L + ARGTAB_OFF + 320); xb_.t0 = (TID_NOW() == 0); xcd_barrier(xb_); }
        }
        int tid = TID_NOW(); asm volatile("" : "+v"(tid));
        int bid = blockIdx.x; asm volatile("" : "+s"(bid));
        int G = gridDim.x; asm volatile("" : "+s"(G));
        unsigned char* ws = a.ws_();
        const int lane = tid & 63, wave = __builtin_amdgcn_readfirstlane(tid >> 6);
        const int gw = wave * G + bid, NGW = G * NWAVES;
        int kind, l;
        if (ph == 0) { kind = K_PRO; l = 0; }
        else if (ph < 13) { l = (ph - 1) / 6; const int k = (ph - 1) % 6; kind = (k == 0) ? K_INPROJ : (k == 1) ? K_RA : (k == 2) ? K_RB : (k == 3) ? K_OUT : (k == 4) ? K_UP : K_DOWN; }
        else { l = 2 + (ph - 13) / 5; const int k = (ph - 13) % 5; kind = (k == 0) ? K_INPROJ : (k == 1) ? K_ATT : (k == 2) ? K_OUT : (k == 3) ? K_UP : K_DOWN; }
        asm volatile("" : "+s"(kind));
        if (kind == K_UP) {
            asm volatile("" : "+s"(l));
            {
                pg8::Gemm g; pg8::StaticOrder S; pg8::EpiFfn E;
                g.A = (const bf16_t*)(ws + WS_XB); g.Bt = (const bf16_t*)(ws + WS_WUP) + (size_t)l * 6144 * DM; g.M = MP; g.N = 6144; g.K = DM;
                S.init(MP, 6144, G, bid);
                E.G = (bf16_t*)(ws + WS_G); E.ssq = (const float*)(ws + WS_SSQ); E.cw = a.in_(I_FCW) + (size_t)l * 3 * 6144; E.cb = a.in_(I_FCB) + (size_t)l * 6144;
                E.hb = (float*)(ws + WS_HB); E.pfc = a.out_() + O_PFC + (size_t)l * 4 * 2 * 6144;
                pg8::gemm_phase<pg8::EpiFfn, pg8::StaticOrder, true, true>(L, g, S, E, tid);
            }
            asm volatile("" : "+s"(l)); asm volatile("" : "+s"(ws));
            {
                const bf16_t* Bt = (const bf16_t*)(ws + WS_WUP) + (size_t)l * 6144 * DM;
                const bf16_t* As = (const bf16_t*)(ws + WS_XB) + (size_t)MP * DM;
                SEpiFfn F{a.in_(I_SFC) + (size_t)l * 128 * 2 * 6144, a.in_(I_FCW) + (size_t)l * 3 * 6144, a.in_(I_FCB) + (size_t)l * 6144, a.out_() + O_SFC + (size_t)l * 128 * 2 * 6144,
                          (bf16_t*)(ws + WS_G), (const float*)(ws + WS_SSQS)};
                small_gemm128(L, As, Bt, 192, bid, G, wave, lane, F);
            }
        } else if (kind == K_INPROJ) {
            asm volatile("" : "+s"(l));
            const int nsub = (kind == K_INPROJ && l == 0) ? 5 : 1;
            const bf16_t* Bt; int N; bf16_t* O; int ldc;
            if (kind == K_UP) { Bt = (const bf16_t*)(ws + WS_WUP) + (size_t)l * 6144 * DM; N = 6144; O = (bf16_t*)(ws + WS_U); ldc = 6144; }
            else if (l < 2) { Bt = (const bf16_t*)(ws + WS_WINA) + (size_t)l * 1792 * DM; N = 1792; O = (bf16_t*)(ws + WS_UIN); ldc = 1792; }
            else if (l == 2) { Bt = (const bf16_t*)(ws + WS_WINB0); N = 1536; O = (bf16_t*)(ws + WS_UIN); ldc = 1536; }
            else { Bt = (const bf16_t*)(ws + WS_WINB1); N = 1024; O = (bf16_t*)(ws + WS_UIN); ldc = 1536; }
            for (int sub = 0; sub < nsub; ++sub) {
                pg8::Gemm g; pg8::StaticOrder S; pg8::EpiScaleBf16 E;
                if (sub < nsub - 1) {
                    g.A = (const bf16_t*)(ws + WS_MEMXB); g.Bt = (const bf16_t*)(ws + WS_WMKV) + (size_t)sub * 512 * DM; g.M = 1024; g.N = 512; g.K = DM;
                    S.init(1024, 512, G, (bid - (192 + 8 * sub) % G + G) % G);
                    E.O = (bf16_t*)(ws + WS_MEMRAW) + (size_t)sub * 1024 * 512; E.ldc = 512; E.ssq = (const float*)(ws + WS_MEMSSQ);
                } else {
                    g.A = (const bf16_t*)(ws + WS_XB); g.Bt = Bt; g.M = MP; g.N = N; g.K = DM;
                    S.init(MP, N, G, bid);
                    E.O = O; E.ldc = ldc; E.ssq = (const float*)(ws + WS_SSQ);
                }
                pg8::gemm_phase<pg8::EpiScaleBf16, pg8::StaticOrder, true, true>(L, g, S, E, tid);
            }
            asm volatile("" : "+s"(l)); asm volatile("" : "+s"(ws));
            if (kind == K_UP) { Bt = (const bf16_t*)(ws + WS_WUP) + (size_t)l * 6144 * DM; N = 6144; }
            else if (l < 2) { Bt = (const bf16_t*)(ws + WS_WINA) + (size_t)l * 1792 * DM; N = 1792; }
            else if (l == 2) { Bt = (const bf16_t*)(ws + WS_WINB0); N = 1536; }
            else { Bt = (const bf16_t*)(ws + WS_WINB1); N = 1024; }
            const bf16_t* As = (const bf16_t*)(ws + WS_XB) + (size_t)MP * DM;
            if (kind == K_UP) {
                SEpiFfn F{a.in_(I_SFC) + (size_t)l * 128 * 2 * 6144, a.in_(I_FCW) + (size_t)l * 3 * 6144, a.in_(I_FCB) + (size_t)l * 6144, a.out_() + O_SFC + (size_t)l * 128 * 2 * 6144,
                          (bf16_t*)(ws + WS_G), (const float*)(ws + WS_SSQS)};
                small_gemm(L, As, Bt, DM, 192, 16, 128, 1, bid, G, wave, lane, F);
            } else {
                SEpiScale F{(float*)(ws + WS_UINS), (const float*)(ws + WS_SSQS)};
                const int nwg = (MP / 256) * (N / 256); const int busy = (l != 0 && nwg > G && nwg < 2 * G) ? nwg - G : 0;
                if (bid >= busy) small_gemm(L, As, Bt, DM, N / 32, 32, 16, 0, bid - busy, G - busy, wave, lane, F);
            }
        } else if (kind == K_OUT || kind == K_DOWN) {
            asm volatile("" : "+s"(l));
            pg8::Gemm g; pg8::StaticOrder S; pg8::EpiResid E;
            const bool first = (kind == K_OUT && l == 0);
            const int K = (kind == K_OUT) ? DM : DFF;
            const bf16_t* A; A = (kind == K_OUT) ? (const bf16_t*)(ws + WS_MIX) : (const bf16_t*)(ws + WS_G);
            const bf16_t* Bt; Bt = (kind == K_OUT) ? (const bf16_t*)(ws + WS_WOUT) + (size_t)l * DM * DM : (const bf16_t*)(ws + WS_WDN) + (size_t)l * DM * DFF;
            g.A = A; g.Bt = Bt; g.M = MP; g.N = DM; g.K = K;
            S.init(MP, DM, G, bid);
            if (kind == K_DOWN) { pg8::Unit u0; if (S.next(0, u0)) ffn_fixup(a, l, u0.pm, tid); }
            E.xb = (bf16_t*)(ws + WS_XB); E.ssq = (float*)(ws + WS_SSQ); E.yout = (kind == K_DOWN && l == 3) ? a.out_() + O_YP : nullptr;
            pg8::gemm_phase<pg8::EpiResid, pg8::StaticOrder, true, true>(L, g, S, E, tid);
            asm volatile("" : "+s"(l)); asm volatile("" : "+s"(ws));
            A = (kind == K_OUT) ? (const bf16_t*)(ws + WS_MIX) : (const bf16_t*)(ws + WS_G);
            Bt = (kind == K_OUT) ? (const bf16_t*)(ws + WS_WOUT) + (size_t)l * DM * DM : (const bf16_t*)(ws + WS_WDN) + (size_t)l * DM * DFF;
            SEpiResid F{first ? a.in_(I_XS) : (const float*)(a.out_() + O_YS), a.out_() + O_YS, (bf16_t*)(ws + WS_XB) + (size_t)MP * DM, (float*)(ws + WS_SSQS)};
            small_gemm(L, A + (size_t)MP * K, Bt, K, 32, 32, 16, 0, bid, G, wave, lane, F);
        } else if (kind == K_RA) {
            asm volatile("" : "+s"(l));
            if (l == 0) memkv_finalize(a, gw, NGW, lane);
            for (int it = bid; it < 1536 + 12 + 128; it += G) { asm volatile("" : "+v"(tid));
                if (it < 1536) rglru_item(a, L, l, 0, it, false, tid);
                else if (it < 1548) rglru_item(a, L, l, 1, it - 1536, true, tid);
                else { const int b = it - 1548;
                    sample_attn_item(a, L, b, 4, 1, 256, a.in_(I_CMK) + ((size_t)l * 128 + b) * 65536, a.in_(I_CMV) + ((size_t)l * 128 + b) * 65536, 1536, a.in_(I_MQNG) + l * 64, false, 0, false, 768, tid); } }
        } else if (kind == K_RB) {
            asm volatile("" : "+s"(l));
            for (int it = bid; it < 768 + 256; it += G) {
                asm volatile("" : "+v"(tid));
                if (it < 768) rglru_scan_item2(a, L, l, 2 * it, tid);
                else memattn_prompt_item(a, L, l, it - 768, tid);
            }
        } else if (kind == K_ATT) {
            asm volatile("" : "+s"(l));
            const int j = l - 2;
            for (int itx = bid; itx < 512 + 256 + 128 + 128; itx += G) {
                asm volatile("" : "+v"(tid));
                const int it = (itx < 256) ? itx + 768 : itx - 256;
                if (it < 512) swa_prompt_item(a, L, j, it, l == 2, tid);
                else if (it < 768) memattn_prompt_item(a, L, l, it - 512, tid);
                else if (it < 896) { const int b = it - 768;
                    sample_attn_item(a, L, b, 12, 3, 128, a.in_(I_CSK) + (size_t)b * 32768, a.in_(I_CSV) + (size_t)b * 32768, 0, a.in_(I_QNG) + j * 64, true, j, l == 2, 0, tid); }
                else { const int b = it - 896;
                    sample_attn_item(a, L, b, 4, 1, 256, a.in_(I_CMK) + ((size_t)l * 128 + b) * 65536, a.in_(I_CMV) + ((size_t)l * 128 + b) * 65536, 768, a.in_(I_MQNG) + l * 64, false, 0, false, 768, tid); }
            }
        }
    }
}

extern "C" void kernel_launch(void* const* d_in, const int* in_sizes, int n_in, void* d_out, int out_size, void* d_ws, size_t ws_size, hipStream_t stream) {
    static int grid = 0;
    if (grid == 0) {
        if (n_in != 35 || out_size != (int)O_END || ws_size < WS_END) { fprintf(stderr, "kernel_launch: unexpected shapes: n_in %d out %d ws %zu (need %zu)\n", n_in, out_size, ws_size, (size_t)WS_END); grid = -1; return; }
        int dev = 0, cus = 0, per_cu = 0;
        hipGetDevice(&dev); hipDeviceGetAttribute(&cus, hipDeviceAttributeMultiprocessorCount, dev);
        if (hipFuncSetAttribute((const void*)fwd_kernel, hipFuncAttributeMaxDynamicSharedMemorySize, LDS_BYTES) != hipSuccess) { fprintf(stderr, "kernel_launch: hipFuncSetAttribute failed\n"); grid = -1; return; }
        if (hipOccupancyMaxActiveBlocksPerMultiprocessor(&per_cu, (const void*)fwd_kernel, NTHREADS, LDS_BYTES) != hipSuccess || per_cu < 1) { fprintf(stderr, "kernel_launch: occupancy query says %d blocks per CU\n", per_cu); per_cu = 1; }
        (void)hipGetLastError();
        grid = cus;
    }
    if (grid < 0) return;
    if (hipMemsetAsync((char*)d_ws + WS_CTL, 0, 16384, stream) != hipSuccess) { fprintf(stderr, "kernel_launch: memset of the barrier word failed\n"); return; }
    KArgs a{};
    for (int i = 0; i < 35; ++i) a.in[i] = (const float*)d_in[i];
    a.out = (float*)d_out; a.ws = (unsigned char*)d_ws;
#if MK_SPLIT
    for (int ph = 0; ph < NPHASES; ++ph) { a.ph_lo = ph; a.ph_hi = ph + 1; hipLaunchKernelGGL(fwd_kernel, dim3(grid), dim3(NTHREADS), LDS_BYTES, stream, a); }
#else
    a.ph_lo = 0; a.ph_hi = NPHASES;
    void* args[] = { &a };
    hipError_t e = hipLaunchCooperativeKernel((const void*)fwd_kernel, dim3(grid), dim3(NTHREADS), args, LDS_BYTES, stream);
    if (e != hipSuccess) fprintf(stderr, "kernel_launch: cooperative launch failed: %s (grid %d)\n", hipGetErrorString(e), grid);
#endif
}
```

```cpp
#include <hip/hip_runtime.h>
#include <hip/hip_cooperative_groups.h>
#include <cstdio>
#include <cstdint>
namespace cg = cooperative_groups;

#ifndef MK_SPLIT
#define MK_SPLIT 0
#endif

#define LAS __attribute__((address_space(3)))
typedef unsigned short bf16_t;
typedef short bf16x8 __attribute__((ext_vector_type(8)));
typedef float f32x4 __attribute__((ext_vector_type(4)));
typedef float f32x2 __attribute__((ext_vector_type(2)));
typedef unsigned u32x4 __attribute__((ext_vector_type(4)));
typedef unsigned u32x2 __attribute__((ext_vector_type(2)));

namespace pg8 {
constexpr int BM = 256, BK = 64, HALF = 128, HTB = HALF * BK * 2, STAGE_BYTES = 8 * HTB, NXCD = 8, WGM = 8;
__host__ __device__ __forceinline__ int lds_byte(int r, int c) { const int st = (r >> 4) * 2 + (c >> 5), rr = r & 15, cc = c & 31, ob = rr * 64 + cc * 2; return st * 1024 + (ob ^ (((ob >> 9) & 1) << 5)); }
__host__ __device__ __forceinline__ void stage_rc(int b, int& R, int& C) { const int st = b / 1024, sb = b % 1024, swz = sb ^ (((sb >> 9) & 1) << 5); R = (st >> 1) * 16 + swz / 64; C = (st & 1) * 32 + (swz % 64) / 2; }
__host__ __device__ __forceinline__ int perm32(int rho) { const int n = rho >> 4, i = rho & 15; return 8 * (i >> 2) + 4 * n + (i & 3); }
struct Unit { int pm, pn; };
struct Gemm { const bf16_t* A; const bf16_t* Bt; int M, N, K; };
struct StaticOrder {
    int nM, nN, nwg, G, c;
    __host__ __device__ void init(int M, int N, int G_, int c_) { nM = M / BM; nN = N / BM; nwg = nM * nN; G = G_; c = c_; }
    __host__ __device__ bool next(int i, Unit& u) const {
        const long L = (long)i * G + c; if (L >= nwg) return false;
        int wgid = (int)L; { const int q = nwg / NXCD, r = nwg % NXCD, xcd = wgid % NXCD, off = wgid / NXCD; wgid = (xcd < r ? xcd * (q + 1) : r * (q + 1) + (xcd - r) * q) + off; }
        const int nig = WGM * nN, gid = wgid / nig, fm = gid * WGM, gsz = (nM - fm) < WGM ? (nM - fm) : WGM;
        u.pm = fm + ((wgid % nig) % gsz); u.pn = (wgid % nig) / gsz; return true;
    }
    __device__ __forceinline__ void a_ready(const Unit&) const {}
    __device__ __forceinline__ void done(const Unit&) const {}
};
__device__ __forceinline__ unsigned cvt_pk_bf16(float lo, float hi) { unsigned r; asm volatile("v_cvt_pk_bf16_f32 %0, %1, %2" : "=v"(r) : "v"(lo), "v"(hi)); return r; }

struct EpiScaleBf16 {
    static constexpr bool PERM = true, AFTER_DRAIN = false, APERM = false;
    bf16_t* O; int ldc; const float* ssq;
    __device__ __forceinline__ void operator()(const f32x4 (&acc)[2][2][4][2], const Unit& u, int wr, int wc, int fr, int fq) const {
        const unsigned row0 = (unsigned)(u.pm * BM + wr * 64 + fr), col0 = (unsigned)(u.pn * BM + wc * 32 + 8 * fq);
        f32x4 pp[2][4];
#pragma unroll
        for (int ai = 0; ai < 2; ++ai)
#pragma unroll
            for (int m = 0; m < 4; ++m) pp[ai][m] = *(const f32x4*)((const char*)ssq + ((row0 + ai * HALF + m * 16) * 16u + 4u * fq) * 4u);
#pragma unroll
        for (int ai = 0; ai < 2; ++ai)
#pragma unroll
            for (int m = 0; m < 4; ++m) {
                const unsigned row = row0 + ai * HALF + m * 16;
                const f32x4 p = pp[ai][m];
                float s = (p[0] + p[1]) + (p[2] + p[3]); s += __shfl_xor(s, 16); s += __shfl_xor(s, 32);
                const float r = __builtin_amdgcn_rsqf(s * (1.0f / 1024.0f) + 1e-6f);
                bf16_t* rowp = O + (size_t)row * ldc + col0;
#pragma unroll
                for (int bj = 0; bj < 2; ++bj) { const f32x4 v0 = acc[ai][bj][m][0] * r, v1 = acc[ai][bj][m][1] * r;
                    u32x4 w; w.x = cvt_pk_bf16(v0[0], v0[1]); w.y = cvt_pk_bf16(v0[2], v0[3]); w.z = cvt_pk_bf16(v1[0], v1[1]); w.w = cvt_pk_bf16(v1[2], v1[3]);
                    *(u32x4*)(rowp + bj * HALF) = w; }
            }
    }
};
struct EpiResid {
    static constexpr bool PERM = true, AFTER_DRAIN = false, APERM = false;
    bf16_t* xb; float* ssq; float* yout;
    __device__ __forceinline__ void operator()(const f32x4 (&acc)[2][2][4][2], const Unit& u, int wr, int wc, int fr, int fq) const {
        const unsigned row0 = (unsigned)(u.pm * BM + wr * 64 + fr), col0 = (unsigned)(u.pn * BM + wc * 32 + 8 * fq);
        u32x4 xw[2][4][2];
#pragma unroll
        for (int ai = 0; ai < 2; ++ai)
#pragma unroll
            for (int m = 0; m < 4; ++m)
#pragma unroll
                for (int bj = 0; bj < 2; ++bj) xw[ai][m][bj] = *(const u32x4*)((const char*)xb + ((row0 + ai * HALF + m * 16) * 1024u + col0 + bj * HALF) * 2u);
#pragma unroll
        for (int ai = 0; ai < 2; ++ai)
#pragma unroll
            for (int m = 0; m < 4; ++m) {
                const unsigned row = row0 + ai * HALF + m * 16; const unsigned off = row * 1024u + col0; float s = 0.f;
#pragma unroll
                for (int bj = 0; bj < 2; ++bj) {
                    const u32x4 x = xw[ai][m][bj];
                    f32x4 o0 = acc[ai][bj][m][0], o1 = acc[ai][bj][m][1];
                    o0[0] += __builtin_bit_cast(float, x.x << 16); o0[1] += __builtin_bit_cast(float, x.x & 0xffff0000u); o0[2] += __builtin_bit_cast(float, x.y << 16); o0[3] += __builtin_bit_cast(float, x.y & 0xffff0000u);
                    o1[0] += __builtin_bit_cast(float, x.z << 16); o1[1] += __builtin_bit_cast(float, x.z & 0xffff0000u); o1[2] += __builtin_bit_cast(float, x.w << 16); o1[3] += __builtin_bit_cast(float, x.w & 0xffff0000u);
                    s += ((o0[0] * o0[0] + o0[1] * o0[1]) + (o0[2] * o0[2] + o0[3] * o0[3])) + ((o1[0] * o1[0] + o1[1] * o1[1]) + (o1[2] * o1[2] + o1[3] * o1[3]));
                    u32x4 w; w.x = cvt_pk_bf16(o0[0], o0[1]); w.y = cvt_pk_bf16(o0[2], o0[3]); w.z = cvt_pk_bf16(o1[0], o1[1]); w.w = cvt_pk_bf16(o1[2], o1[3]);
                    *(u32x4*)((char*)xb + (off + bj * HALF) * 2u) = w;
                    if (yout) { *(f32x4*)((char*)yout + (off + bj * HALF) * 4u) = o0; *(f32x4*)((char*)yout + (off + bj * HALF + 4u) * 4u) = o1; }
                }
                s += __shfl_xor(s, 16); s += __shfl_xor(s, 32);
                if (fq == 0) ssq[(size_t)row * 16 + u.pn * 4 + wc] = s;
            }
    }
};

__device__ __forceinline__ float dpp_prev(float oldv, float srcv, const int ctrl_is_2) {
    return ctrl_is_2 ? __builtin_bit_cast(float, __builtin_amdgcn_update_dpp(__builtin_bit_cast(int, oldv), __builtin_bit_cast(int, srcv), 0x112, 0xf, 0xf, false))
                     : __builtin_bit_cast(float, __builtin_amdgcn_update_dpp(__builtin_bit_cast(int, oldv), __builtin_bit_cast(int, srcv), 0x111, 0xf, 0xf, false));
}
__device__ __forceinline__ float dpp_ror1(float v) { return __builtin_bit_cast(float, __builtin_amdgcn_update_dpp(0, __builtin_bit_cast(int, v), 0x121, 0xf, 0xf, false)); }
__device__ __forceinline__ float dpp_ror2(float v) { return __builtin_bit_cast(float, __builtin_amdgcn_update_dpp(0, __builtin_bit_cast(int, v), 0x122, 0xf, 0xf, false)); }
__device__ __forceinline__ float gelu_t(float x) { const float x2 = x * x; const float t = __builtin_fmaf(x2, -0.1029432f, -2.3022082f);
    const float e = __builtin_amdgcn_exp2f(t * x); return x * __builtin_amdgcn_rcpf(1.0f + e); }
struct EpiFfn {
    static constexpr bool PERM = true, AFTER_DRAIN = false, APERM = true;
    bf16_t* G; const float* ssq; const float* cw; const float* cb; float* hb; float* pfc;
    __device__ __forceinline__ void operator()(f32x4 (&acc)[2][2][4][2], const Unit& u, int wr, int wc, int fr, int fq) const {
        const unsigned base0 = (unsigned)(u.pm * BM + wr * 64), row0 = base0 + 4u * fr, cc0 = (unsigned)(u.pn * 128 + wc * 32 + 8 * fq);
        f32x4 wt[2][3], bs[2];
        {
            f32x4 pp[2][4];
#pragma unroll
            for (int ai = 0; ai < 2; ++ai)
#pragma unroll
                for (int m = 0; m < 4; ++m) pp[ai][m] = *(const f32x4*)((const char*)ssq + ((row0 + ai * HALF + m) * 16u + 4u * fq) * 4u);
#pragma unroll
            for (int hf = 0; hf < 2; ++hf) {
#pragma unroll
                for (int jx = 0; jx < 3; ++jx) wt[hf][jx] = *(const f32x4*)((const char*)cw + cc0 * 4u + (jx * 6144 + hf * 3072) * 4);
                bs[hf] = *(const f32x4*)((const char*)cb + cc0 * 4u + hf * 3072 * 4); }
#pragma unroll
            for (int ai = 0; ai < 2; ++ai)
#pragma unroll
                for (int m = 0; m < 4; ++m) {
                    const f32x4 p = pp[ai][m];
                    float s = (p[0] + p[1]) + (p[2] + p[3]); s += __shfl_xor(s, 16); s += __shfl_xor(s, 32);
                    const float r = __builtin_amdgcn_rsqf(s * (1.0f / 1024.0f) + 1e-6f);
#pragma unroll
                    for (int bj = 0; bj < 2; ++bj)
#pragma unroll
                        for (int n = 0; n < 2; ++n) acc[ai][bj][m][n] *= r;
                }
        }
        __builtin_amdgcn_sched_barrier(0);
#pragma unroll
        for (int ai = 0; ai < 2; ++ai) {
            const unsigned grp = (base0 + ai * HALF) >> 6;
            if (fr == 0) {
#pragma unroll
                for (int m = 0; m < 2; ++m) { const unsigned ob = ((grp * 4u + m) * 6144u + cc0) * 4u;
#pragma unroll
                    for (int bj = 0; bj < 2; ++bj)
#pragma unroll
                        for (int n = 0; n < 2; ++n) *(f32x4*)((char*)hb + ob + (bj * 3072 + 4 * n) * 4) = acc[ai][bj][m][n]; } }
            if (fr == 15) {
#pragma unroll
                for (int m = 2; m < 4; ++m) { const unsigned ob = ((grp * 4u + m) * 6144u + cc0) * 4u;
#pragma unroll
                    for (int bj = 0; bj < 2; ++bj)
#pragma unroll
                        for (int n = 0; n < 2; ++n) *(f32x4*)((char*)hb + ob + (bj * 3072 + 4 * n) * 4) = acc[ai][bj][m][n];
                    if (((base0 + ai * HALF + 63u) & 4095u) == 4095u) { const unsigned ob2 = ((((base0 + ai * HALF) >> 12) * 2u + (m - 2)) * 6144u + cc0) * 4u;
#pragma unroll
                        for (int bj = 0; bj < 2; ++bj)
#pragma unroll
                            for (int n = 0; n < 2; ++n) *(f32x4*)((char*)pfc + ob2 + (bj * 3072 + 4 * n) * 4) = acc[ai][bj][m][n]; } } }
        }
        __builtin_amdgcn_sched_barrier(0);
#pragma unroll
        for (int n = 0; n < 2; ++n) {
            if (n == 1) {
#pragma unroll
                for (int hf = 0; hf < 2; ++hf) {
#pragma unroll
                    for (int jx = 0; jx < 3; ++jx) wt[hf][jx] = *(const f32x4*)((const char*)cw + (cc0 + 4u) * 4u + (jx * 6144 + hf * 3072) * 4);
                    bs[hf] = *(const f32x4*)((const char*)cb + (cc0 + 4u) * 4u + hf * 3072 * 4); }
            }
#pragma unroll
            for (int ai = 0; ai < 2; ++ai) {
                f32x4 v[4][2];
#pragma unroll
                for (int hf = 0; hf < 2; ++hf) {
                    f32x4 l3, l2;
#pragma unroll
                    for (int i = 0; i < 4; ++i) { l3[i] = dpp_prev(0.f, acc[ai][hf][3][n][i], 0); l2[i] = dpp_prev(0.f, acc[ai][hf][2][n][i], 0); }
                    const f32x4 x0 = acc[ai][hf][0][n], x1 = acc[ai][hf][1][n], x2 = acc[ai][hf][2][n], x3 = acc[ai][hf][3][n];
                    v[0][hf] = bs[hf] + l2 * wt[hf][0] + l3 * wt[hf][1] + x0 * wt[hf][2];
                    v[1][hf] = bs[hf] + l3 * wt[hf][0] + x0 * wt[hf][1] + x1 * wt[hf][2];
                    v[2][hf] = bs[hf] + x0 * wt[hf][0] + x1 * wt[hf][1] + x2 * wt[hf][2];
                    v[3][hf] = bs[hf] + x1 * wt[hf][0] + x2 * wt[hf][1] + x3 * wt[hf][2];
                }
#pragma unroll
                for (int m = 0; m < 4; ++m) {
                    u32x2 w; w.x = cvt_pk_bf16(gelu_t(v[m][0][0]) * v[m][1][0], gelu_t(v[m][0][1]) * v[m][1][1]); w.y = cvt_pk_bf16(gelu_t(v[m][0][2]) * v[m][1][2], gelu_t(v[m][0][3]) * v[m][1][3]);
                    const unsigned gb = ((row0 + ai * HALF + m) * 3072u + cc0 + 4u * n) * 2u;
                    if (m >= 2 || fr > 0) *(u32x2*)((char*)G + gb) = w;
                }
            }
        }
    }
};

template <class Epi, class Sched, bool ALIGN_EPI = false, bool SP2 = false>
__device__ __forceinline__ void gemm_phase(LAS unsigned char* lds, const Gemm g, const Sched& S, const Epi& E, const int tid) {
    const int wid = __builtin_amdgcn_readfirstlane(tid >> 6), lane = tid & 63, wr = wid >> 2, wc = wid & 3, fr = lane & 15, fq = lane >> 4;
    const int K = g.K, nt = K / BK;
    unsigned voffA[2], voffB[2];
#pragma unroll
    for (int i = 0; i < 2; ++i) { int R, C; stage_rc(tid * 16 + i * 8192, R, C); const int Rb = Epi::PERM ? ((R & ~31) + perm32(R & 31)) : R;
        const int Ra = Epi::APERM ? ((R & 64) | ((R & 15) << 2) | ((R >> 4) & 3)) : R;
        voffA[i] = (unsigned)(Ra * K + C) * 2u; voffB[i] = (unsigned)(Rb * K + C) * 2u; }
    const size_t kstep = (size_t)(BK * 2);
    const size_t hstep = (size_t)HALF * K * 2;
    const size_t tstep = 2 * hstep;
    const unsigned ldsw = (unsigned)wid * 1024u;
    const int aoff = lds_byte(wr * 64 + fr, fq * 8), boff = lds_byte(wc * 32 + fr, fq * 8);
#define PG8_SA(b, h) (((b) * 2 + (h)) * HTB)
#define PG8_SB(b, h) ((4 + (b) * 2 + (h)) * HTB)
#define PG8_STAGE(bufoff, gbase, voff) do { _Pragma("unroll") for (int _i = 0; _i < 2; ++_i) \
        __builtin_amdgcn_global_load_lds((const unsigned*)((const char*)(gbase) + (voff)[_i]), (LAS unsigned*)(lds + (bufoff) + ldsw + _i * 8192), 16, 0, 0); } while (0)
#define PG8_LDA(dst, b, h) do { _Pragma("unroll") for (int m = 0; m < 4; ++m) _Pragma("unroll") for (int k = 0; k < 2; ++k) dst[m][k] = *(const LAS bf16x8*)(lds + PG8_SA(b, h) + aoff + m * 2048 + k * 1024); } while (0)
#define PG8_LDB(dst, b, h) do { _Pragma("unroll") for (int n = 0; n < 2; ++n) _Pragma("unroll") for (int k = 0; k < 2; ++k) dst[n][k] = *(const LAS bf16x8*)(lds + PG8_SB(b, h) + boff + n * 2048 + k * 1024); } while (0)
#define PG8_MMA(ai, bj, At, Bt) do { __builtin_amdgcn_s_setprio(1); _Pragma("unroll") for (int m = 0; m < 4; ++m) _Pragma("unroll") for (int n = 0; n < 2; ++n) _Pragma("unroll") for (int k = 0; k < 2; ++k) \
        acc[ai][bj][m][n] = __builtin_amdgcn_mfma_f32_16x16x32_bf16(Bt[n][k], At[m][k], acc[ai][bj][m][n], 0, 0, 0); __builtin_amdgcn_s_setprio(0); } while (0)
#define PG8_WAIT_V(n) asm volatile("s_waitcnt vmcnt(" #n ")" ::: "memory")
#define PG8_WAIT_L(n) asm volatile("s_waitcnt lgkmcnt(" #n ")" ::: "memory")
#define PG8_BAR __builtin_amdgcn_s_barrier()
#define PG8_SCHED __builtin_amdgcn_sched_barrier(0)
    Unit cur, nxt; int ui = 0;
    if (!S.next(0, cur)) return;
    f32x4 acc[2][2][4][2];
#pragma unroll
    for (int a = 0; a < 2; ++a)
#pragma unroll
        for (int b = 0; b < 2; ++b)
#pragma unroll
            for (int m = 0; m < 4; ++m)
#pragma unroll
                for (int n = 0; n < 2; ++n) acc[a][b][m][n] = (f32x4){0.f, 0.f, 0.f, 0.f};
    bf16x8 At[4][2], B0[2][2], B1[2][2];
    const char* cA = (const char*)g.A + (size_t)cur.pm * tstep; const char* cB = (const char*)g.Bt + (size_t)cur.pn * tstep;
    S.a_ready(cur);
    if constexpr (SP2) {
        PG8_STAGE(PG8_SB(0, 0), cB, voffB); PG8_STAGE(PG8_SB(0, 1), cB + hstep, voffB); PG8_STAGE(PG8_SA(0, 0), cA, voffA); PG8_STAGE(PG8_SA(0, 1), cA + hstep, voffA);
        if (wr == 1) PG8_BAR;
        PG8_WAIT_V(2); PG8_BAR;
        PG8_STAGE(PG8_SB(1, 0), cB + kstep, voffB); PG8_STAGE(PG8_SA(1, 0), cA + kstep, voffA); PG8_STAGE(PG8_SB(1, 1), cB + hstep + kstep, voffB);
        PG8_WAIT_V(6); PG8_BAR;
    } else {
        PG8_STAGE(PG8_SB(0, 0), cB, voffB); PG8_STAGE(PG8_SA(0, 0), cA, voffA); PG8_STAGE(PG8_SB(0, 1), cB + hstep, voffB); PG8_STAGE(PG8_SA(0, 1), cA + hstep, voffA);
        if (wr == 1) PG8_BAR;
        PG8_WAIT_V(4); PG8_BAR;
        PG8_STAGE(PG8_SB(1, 0), cB + kstep, voffB); PG8_STAGE(PG8_SA(1, 0), cA + kstep, voffA); PG8_STAGE(PG8_SB(1, 1), cB + hstep + kstep, voffB);
        PG8_WAIT_V(6); PG8_BAR;
    }
    for (;;) {
        const bool has_next = S.next(ui + 1, nxt);
        const char* nA = has_next ? (const char*)g.A + (size_t)nxt.pm * tstep : cA; const char* nB = has_next ? (const char*)g.Bt + (size_t)nxt.pn * tstep : cB;
        for (int t = 0; t < nt; t += 2) {
            const bool last = (t == nt - 2);
            const char* a1 = cA + (size_t)(t + 1) * kstep;
            const char* a2 = last ? nA : cA + (size_t)(t + 2) * kstep; const char* b2 = last ? nB : cB + (size_t)(t + 2) * kstep;
            const char* a3 = a2 + kstep; const char* b3 = b2 + kstep;
            if (last && has_next) S.a_ready(nxt);
            if constexpr (SP2) {
            PG8_LDB(B0, 0, 0); PG8_LDB(B1, 0, 1); PG8_SCHED; PG8_LDA(At, 0, 0); PG8_STAGE(PG8_SA(1, 1), a1 + hstep, voffA);
            PG8_WAIT_V(8); PG8_WAIT_L(0); PG8_BAR; PG8_MMA(0, 0, At, B0); PG8_MMA(0, 1, At, B1); PG8_BAR; PG8_SCHED;
            PG8_LDA(At, 0, 1); PG8_STAGE(PG8_SB(0, 0), b2, voffB); PG8_STAGE(PG8_SB(0, 1), b2 + hstep, voffB); PG8_STAGE(PG8_SA(0, 0), a2, voffA);
            PG8_WAIT_V(8); PG8_WAIT_L(0); PG8_BAR; PG8_MMA(1, 0, At, B0); PG8_MMA(1, 1, At, B1); PG8_BAR; PG8_SCHED;
            PG8_LDB(B0, 1, 0); PG8_LDB(B1, 1, 1); PG8_SCHED; PG8_LDA(At, 1, 0); PG8_STAGE(PG8_SA(0, 1), a2 + hstep, voffA);
            PG8_WAIT_V(8); PG8_WAIT_L(0); PG8_BAR; PG8_MMA(0, 0, At, B0); PG8_MMA(0, 1, At, B1); PG8_BAR; PG8_SCHED;
            PG8_LDA(At, 1, 1); PG8_STAGE(PG8_SB(1, 0), b3, voffB); PG8_STAGE(PG8_SB(1, 1), b3 + hstep, voffB); PG8_STAGE(PG8_SA(1, 0), a3, voffA);
            PG8_WAIT_V(8); PG8_WAIT_L(0); PG8_BAR; PG8_MMA(1, 0, At, B0); PG8_MMA(1, 1, At, B1); PG8_BAR; PG8_SCHED;
            } else {
            PG8_LDB(B0, 0, 0); PG8_SCHED; PG8_LDA(At, 0, 0); PG8_STAGE(PG8_SA(1, 1), a1 + hstep, voffA);
            PG8_WAIT_L(8); PG8_BAR; PG8_WAIT_L(0); PG8_MMA(0, 0, At, B0); PG8_BAR; PG8_SCHED;
            PG8_LDB(B1, 0, 1); PG8_STAGE(PG8_SB(0, 0), b2, voffB);
            PG8_BAR; PG8_WAIT_L(0); PG8_MMA(0, 1, At, B1); PG8_BAR;
            PG8_LDA(At, 0, 1); PG8_STAGE(PG8_SA(0, 0), a2, voffA);
            PG8_BAR; PG8_WAIT_L(0); PG8_MMA(1, 0, At, B0); PG8_BAR; PG8_SCHED;
            PG8_STAGE(PG8_SB(0, 1), b2 + hstep, voffB);
            PG8_WAIT_V(6); PG8_BAR; PG8_MMA(1, 1, At, B1); PG8_BAR;
            PG8_LDB(B0, 1, 0); PG8_SCHED; PG8_LDA(At, 1, 0); PG8_STAGE(PG8_SA(0, 1), a2 + hstep, voffA);
            PG8_WAIT_L(8); PG8_BAR; PG8_WAIT_L(0); PG8_MMA(0, 0, At, B0); PG8_BAR; PG8_SCHED;
            PG8_LDB(B1, 1, 1); PG8_STAGE(PG8_SB(1, 0), b3, voffB);
            PG8_BAR; PG8_WAIT_L(0); PG8_MMA(0, 1, At, B1); PG8_BAR;
            PG8_LDA(At, 1, 1); PG8_STAGE(PG8_SA(1, 0), a3, voffA);
            PG8_BAR; PG8_WAIT_L(0); PG8_MMA(1, 0, At, B0); PG8_BAR; PG8_SCHED;
            PG8_STAGE(PG8_SB(1, 1), b3 + hstep, voffB);
            PG8_WAIT_V(6); PG8_BAR; PG8_MMA(1, 1, At, B1); PG8_BAR;
            }
        }
        if constexpr (ALIGN_EPI) { if (wr == 0) PG8_BAR; }
        if constexpr (!Epi::AFTER_DRAIN) { E(acc, cur, wr, wc, fr, fq); S.done(cur); }
        if (!has_next) break;
#pragma unroll
        for (int a = 0; a < 2; ++a)
#pragma unroll
            for (int b = 0; b < 2; ++b)
#pragma unroll
                for (int m = 0; m < 4; ++m)
#pragma unroll
                    for (int n = 0; n < 2; ++n) acc[a][b][m][n] = (f32x4){0.f, 0.f, 0.f, 0.f};
        cur = nxt; cA = nA; cB = nB; ++ui;
        if constexpr (ALIGN_EPI) { if (wr == 1) PG8_BAR; }
    }
    PG8_WAIT_V(0);
    if constexpr (!ALIGN_EPI) { if (wr == 0) PG8_BAR; }
    PG8_BAR;
#undef PG8_SA
#undef PG8_SB
#undef PG8_STAGE
#undef PG8_LDA
#undef PG8_LDB
#undef PG8_MMA
#undef PG8_WAIT_V
#undef PG8_WAIT_L
#undef PG8_BAR
#undef PG8_SCHED
}
}

constexpr int DM = 1024, SEQ = 4096, NBATCH = 4, MP = 16384, MS = 128, DFF = 3072, DRNN = 768;
constexpr int NTHREADS = 512, NWAVES = 8;
constexpr int LDS_BYTES = 147456;
constexpr size_t O_YP = 0, O_YS = 16777216, O_PH = 16908288, O_PRC = 16914432, O_PFC = 16932864, O_PK = 17129472, O_PV = 17260544,
                 O_PMK = 17391616, O_PMV = 18440192, O_SH = 19488768, O_SRC = 19685376, O_SFC = 20275200, O_SK = 26566656, O_SV = 26599424, O_END = 26632192;
constexpr size_t MiB = 1u << 20;
constexpr size_t WS_WINA = 0, WS_WINB0 = 8 * MiB, WS_WINB1 = 12 * MiB, WS_WOUT = 16 * MiB, WS_WUP = 24 * MiB, WS_WDN = 72 * MiB, WS_WMKV = 96 * MiB;
constexpr size_t WS_XB = 104 * MiB, WS_SSQ = 140 * MiB, WS_SSQS = 141 * MiB, WS_MEMSSQ = 141 * MiB + 512 * 1024, WS_MEMXB = 142 * MiB, WS_MEMRAW = 144 * MiB;
constexpr size_t WS_MK = 148 * MiB, WS_MVT = 150 * MiB, WS_ROPEC = 152 * MiB, WS_ROPES = 153 * MiB, WS_CARA = 154 * MiB, WS_CARB = 155 * MiB, WS_UINS = 156 * MiB;
constexpr size_t WS_WG = 157 * MiB;
constexpr size_t WS_HB = 356 * MiB + 128 * MiB;
constexpr size_t WS_CTL = 141 * MiB + 256 * 1024;
constexpr size_t WS_MIX = 160 * MiB, WS_UIN = 196 * MiB, WS_G = 256 * MiB, WS_U = 356 * MiB, WS_END = 548 * MiB;

struct KArgs { const float* in[35]; float* out; unsigned char* ws; int ph_lo, ph_hi; };
constexpr int ARGTAB_OFF = LDS_BYTES - 512;
struct Args {
    LAS const unsigned* t;
    __device__ __forceinline__ unsigned long long ld(int i) const { const unsigned lo = __builtin_amdgcn_readfirstlane(t[2 * i]), hi = __builtin_amdgcn_readfirstlane(t[2 * i + 1]); return ((unsigned long long)hi << 32) | lo; }
    __device__ __forceinline__ const float* in_(int i) const { return (const float*)ld(i); }
    __device__ __forceinline__ float* out_() const { return (float*)ld(35); }
    __device__ __forceinline__ unsigned char* ws_() const { return (unsigned char*)ld(36); }
};
enum { I_XP = 0, I_XS, I_SH, I_SRC, I_SFC, I_CSK, I_CSV, I_CMK, I_CMV, I_MEMP, I_NMG, I_NFG, I_WINA, I_RCW, I_RCB, I_WGX, I_BGX, I_WGA, I_BGA, I_LRU,
       I_WINB, I_QNG, I_SINK, I_KVNG, I_WKV, I_KNG, I_MNG, I_WMKV, I_MQNG, I_MKNG, I_WOUT, I_WUP, I_FCW, I_FCB, I_WDN };

__device__ __forceinline__ unsigned f2bf(float f) { unsigned u = __builtin_bit_cast(unsigned, f); return (u + 0x7fffu + ((u >> 16) & 1u)) >> 16; }
__device__ __forceinline__ unsigned pk2(float lo, float hi) { return f2bf(lo) | (f2bf(hi) << 16); }
__device__ __forceinline__ float bf2f(unsigned b) { return __builtin_bit_cast(float, b << 16); }
__device__ __forceinline__ float bflo(unsigned w) { return __builtin_bit_cast(float, w << 16); }
__device__ __forceinline__ float bfhi(unsigned w) { return __builtin_bit_cast(float, w & 0xffff0000u); }
__device__ __forceinline__ float gelu_tanh(float x) { const float x2 = x * x; const float t = __builtin_fmaf(x2, -0.1029432f, -2.3022082f); const float e = __builtin_amdgcn_exp2f(t * x); return x * __builtin_amdgcn_rcpf(1.0f + e); }
__device__ __forceinline__ float sigmoidf_(float x) { return __builtin_amdgcn_rcpf(1.0f + __builtin_amdgcn_exp2f(-1.4426950408889634f * x)); }
__device__ __forceinline__ float wave_sum(float v) {
#pragma unroll
    for (int o = 1; o < 64; o <<= 1) v += __shfl_xor(v, o);
    return v;
}
__device__ __forceinline__ float wave_max(float v) {
#pragma unroll
    for (int o = 1; o < 64; o <<= 1) v = fmaxf(v, __shfl_xor(v, o));
    return v;
}
__device__ __forceinline__ f32x4 mfma16(bf16x8 a, bf16x8 b, f32x4 c) { return __builtin_amdgcn_mfma_f32_16x16x32_bf16(a, b, c, 0, 0, 0); }

struct WDesc { const float* W; const float* gain; bf16_t* WT; int K, N, pair; };
__device__ __forceinline__ WDesc wdesc(const Args& a, int mi) {
    WDesc d; unsigned char* ws = a.ws_(); d.pair = 0;
    if (mi < 2)       { d.W = a.in_(I_WINA) + (size_t)mi * DM * 1792; d.gain = a.in_(I_NMG) + mi * DM; d.WT = (bf16_t*)(ws + WS_WINA) + (size_t)mi * 1792 * DM; d.K = DM; d.N = 1792; }
    else if (mi == 2) { d.W = a.in_(I_WINB); d.gain = a.in_(I_NMG) + 2 * DM; d.WT = (bf16_t*)(ws + WS_WINB0); d.K = DM; d.N = 1024; }
    else if (mi == 3) { d.W = a.in_(I_WKV); d.gain = a.in_(I_KVNG); d.WT = (bf16_t*)(ws + WS_WINB0) + (size_t)1024 * DM; d.K = DM; d.N = 512; }
    else if (mi == 4) { d.W = a.in_(I_WINB) + (size_t)DM * 1024; d.gain = a.in_(I_NMG) + 3 * DM; d.WT = (bf16_t*)(ws + WS_WINB1); d.K = DM; d.N = 1024; }
    else if (mi < 9)  { const int l = mi - 5;  d.W = a.in_(I_WOUT) + (size_t)l * DM * DM; d.gain = nullptr; d.WT = (bf16_t*)(ws + WS_WOUT) + (size_t)l * DM * DM; d.K = DM; d.N = DM; }
    else if (mi < 13) { const int l = mi - 9;  d.W = a.in_(I_WUP) + (size_t)l * DM * 6144; d.gain = a.in_(I_NFG) + l * DM; d.WT = (bf16_t*)(ws + WS_WUP) + (size_t)l * 6144 * DM; d.K = DM; d.N = 6144; d.pair = 1; }
    else if (mi < 17) { const int l = mi - 13; d.W = a.in_(I_WDN) + (size_t)l * DFF * DM; d.gain = nullptr; d.WT = (bf16_t*)(ws + WS_WDN) + (size_t)l * DM * DFF; d.K = DFF; d.N = DM; }
    else              { const int l = mi - 17; d.W = a.in_(I_WMKV) + (size_t)l * DM * 512; d.gain = a.in_(I_MNG) + l * DM; d.WT = (bf16_t*)(ws + WS_WMKV) + (size_t)l * 512 * DM; d.K = DM; d.N = 512; }
    return d;
}
__device__ __forceinline__ void transpose_item(const WDesc& d, LAS float* scr, int item, int tid) {
    const int nblk = d.N / 128, kb = item / nblk, nb = item % nblk, k0 = 128 * kb, n0 = 128 * nb;
    {
        const int c4 = tid & 31, r0 = tid >> 5;
#pragma unroll
        for (int p = 0; p < 8; ++p) { const int kk = r0 + 16 * p;
            f32x4 v = *(const f32x4*)(d.W + (size_t)(k0 + kk) * d.N + n0 + 4 * c4);
            if (d.gain) v *= d.gain[k0 + kk];
            LAS float* s = scr + kk * 129 + 4 * c4; s[0] = v[0]; s[1] = v[1]; s[2] = v[2]; s[3] = v[3]; }
    }
    __syncthreads();
    {
        const int c = tid & 15, nr = tid >> 4;
#pragma unroll
        for (int p = 0; p < 4; ++p) { const int n = nr + 32 * p; const LAS float* s = scr + (8 * c) * 129 + n;
            u32x4 o; o.x = pk2(s[0 * 129], s[1 * 129]); o.y = pk2(s[2 * 129], s[3 * 129]); o.z = pk2(s[4 * 129], s[5 * 129]); o.w = pk2(s[6 * 129], s[7 * 129]);
            int orow = n0 + n; if (d.pair) { const int hf = orow / DFF, cc = orow % DFF; orow = (cc >> 7) * 256 + hf * 128 + (cc & 127); }
            *(u32x4*)(d.WT + (size_t)orow * d.K + k0 + 8 * c) = o; }
    }
    __syncthreads();
}
__device__ __forceinline__ void row_to_bf16(const float* xrow, bf16_t* orow, float* ssq, int nslot, int lane) {
    const f32x4* xr = (const f32x4*)xrow + lane; float s = 0.f;
    unsigned long long* o8 = (unsigned long long*)orow + lane;
#pragma unroll
    for (int j = 0; j < 4; ++j) { const f32x4 v = xr[64 * j]; s += (v[0] * v[0] + v[1] * v[1]) + (v[2] * v[2] + v[3] * v[3]);
        o8[64 * j] = (unsigned long long)pk2(v[0], v[1]) | ((unsigned long long)pk2(v[2], v[3]) << 32); }
    s = wave_sum(s);
    if (lane < nslot) ssq[lane] = (lane == 0) ? s : 0.f;
}
__device__ __forceinline__ void prologue(const Args& a, LAS unsigned char* L, int gw, int NGW, int wave, int lane) {
    LAS float* scr = (LAS float*)L;
    {
        const int G = NGW / NWAVES, bid = gw % G, tid = wave * 64 + lane;
        int it = bid, mi = 0, base = 0;
        WDesc d = wdesc(a, 0); int cnt = (d.K / 128) * (d.N / 128);
        while (mi < 21) {
            if (it < base + cnt) { transpose_item(d, scr, it - base, tid); it += G; }
            else { base += cnt; ++mi; if (mi < 21) { d = wdesc(a, mi); cnt = (d.K / 128) * (d.N / 128); } }
        }
    }
    unsigned char* ws = a.ws_();
    for (int m = gw; m < MP + MS + 1024; m += NGW) {
        if (m < MP) row_to_bf16(a.in_(I_XP) + (size_t)m * DM, (bf16_t*)(ws + WS_XB) + (size_t)m * DM, (float*)(ws + WS_SSQ) + (size_t)m * 16, 16, lane);
        else if (m < MP + MS) { const int r = m - MP; row_to_bf16(a.in_(I_XS) + (size_t)r * DM, (bf16_t*)(ws + WS_XB) + (size_t)m * DM, (float*)(ws + WS_SSQS) + (size_t)r * 32, 32, lane); }
        else { const int r = m - MP - MS; row_to_bf16(a.in_(I_MEMP) + (size_t)r * DM, (bf16_t*)(ws + WS_MEMXB) + (size_t)r * DM, (float*)(ws + WS_MEMSSQ) + (size_t)r * 16, 16, lane); }
    }
    {
        bf16_t* wg = (bf16_t*)(ws + WS_WG);
        for (int idx = gw * 64 + lane; idx < 2 * 12 * 2 * 4096; idx += NGW * 64) {
            const int k = idx & 63, j = (idx >> 6) & 63, g = (idx >> 12) & 1, ln = idx >> 13;
            const float* wsrc = (g ? a.in_(I_WGA) : a.in_(I_WGX)) + (size_t)ln * 4096;
            wg[idx] = (bf16_t)f2bf(wsrc[k * 64 + j]);
        }
    }
    float* rc = (float*)(ws + WS_ROPEC); float* rs = (float*)(ws + WS_ROPES);
    for (int idx = gw * 64 + lane; idx < 4097 * 32; idx += NGW * 64) {
        const int p = idx >> 5, i = idx & 31; const double pos = (p == 4096) ? 8192.0 : (double)p;
        double inv = 1.0; for (int k = 0; k < i; ++k) inv *= 0.74989420933245582;
        const double ang = pos * inv; const double n = __builtin_rint(ang * 0.63661977236758134); const double r = ang - n * 1.5707963267948966;
        const double r2 = r * r;
        const double sn = r * (1.0 + r2 * (-1.0 / 6 + r2 * (1.0 / 120 + r2 * (-1.0 / 5040 + r2 * (1.0 / 362880 - r2 * (1.0 / 39916800))))));
        const double cs = 1.0 + r2 * (-0.5 + r2 * (1.0 / 24 + r2 * (-1.0 / 720 + r2 * (1.0 / 40320 - r2 * (1.0 / 3628800)))));
        const int qd = ((int)n) & 3; double c, s;
        if (qd == 0) { c = cs; s = sn; } else if (qd == 1) { c = -sn; s = cs; } else if (qd == 2) { c = -cs; s = -sn; } else { c = sn; s = -cs; }
        rc[idx] = (float)c; rs[idx] = (float)s;
    }
}

__device__ __forceinline__ void memkv_finalize(const Args& a, int gw, int NGW, int lane) {
    unsigned char* ws = a.ws_();
    for (int t = gw; t < 4 * 1024; t += NGW) {
        const int l = t >> 10, row = t & 1023, b = row >> 8, m = row & 255;
        const bf16_t* raw = (const bf16_t*)(ws + WS_MEMRAW) + (size_t)t * 512;
        const u32x4 w = *(const u32x4*)(raw + lane * 8);
        float v[8] = { bflo(w.x), bfhi(w.x), bflo(w.y), bfhi(w.y), bflo(w.z), bfhi(w.z), bflo(w.w), bfhi(w.w) };
        float s = 0.f;
#pragma unroll
        for (int e = 0; e < 8; ++e) s += v[e] * v[e];
        s += __shfl_xor(s, 1); s += __shfl_xor(s, 2); s += __shfl_xor(s, 4);
        const int h = (lane >> 3) & 3, d0 = (lane & 7) * 8;
        if (lane < 32) {
            const float r = 1.0f / sqrtf(s * (1.0f / 64.0f) + 1e-6f); const float* g = a.in_(I_MKNG) + l * 64 + d0;
#pragma unroll
            for (int e = 0; e < 8; ++e) v[e] = v[e] * r * g[e];
            float* o = a.out_() + O_PMK + ((size_t)(l * 4 + b) * 256 + m) * 256 + h * 64 + d0;
            *(f32x4*)o = (f32x4){v[0], v[1], v[2], v[3]}; *(f32x4*)(o + 4) = (f32x4){v[4], v[5], v[6], v[7]};
            u32x4 p; p.x = pk2(v[0], v[1]); p.y = pk2(v[2], v[3]); p.z = pk2(v[4], v[5]); p.w = pk2(v[6], v[7]);
            *(u32x4*)((bf16_t*)(ws + WS_MK) + ((size_t)((l * 4 + b) * 4 + h) * 256 + m) * 64 + d0) = p;
        } else {
            float* o = a.out_() + O_PMV + ((size_t)(l * 4 + b) * 256 + m) * 256 + h * 64 + d0;
            *(f32x4*)o = (f32x4){v[0], v[1], v[2], v[3]}; *(f32x4*)(o + 4) = (f32x4){v[4], v[5], v[6], v[7]};
            bf16_t* vt = (bf16_t*)(ws + WS_MVT) + ((size_t)((l * 4 + b) * 4 + h) * 64 + d0) * 256 + m;
#pragma unroll
            for (int e = 0; e < 8; ++e) vt[e * 256] = (bf16_t)f2bf(v[e]);
        }
    }
}

template <class F>
__device__ __forceinline__ void small_gemm(LAS unsigned char* L, const bf16_t* A, const bf16_t* Bt, int K, int ncg, int cstride, int c1off, int tilemap, int bid, int G, int wave, int lane, const F& f) {
    const int fr = lane & 15, q = lane >> 4;
    const int kw = K >> 3;
    LAS f32x4* red = (LAS f32x4*)L;
    for (int task = bid; task < 8 * ncg; task += G) {
        const int rg = task & 7, cgi = task >> 3, ccol = cgi * cstride, n0 = tilemap ? (cgi >> 3) * 256 + (cgi & 7) * 16 : ccol;
        const bf16_t* ap = A + (size_t)(rg * 16 + fr) * K + wave * kw + 8 * q;
        const bf16_t* b0p = Bt + (size_t)(n0 + fr) * K + wave * kw + 8 * q; const bf16_t* b1p = b0p + (size_t)c1off * K;
        f32x4 acc0 = (f32x4){0.f, 0.f, 0.f, 0.f}, acc1 = acc0;
        if (kw == 384) {
            bf16x8 av[12], b0[12], b1[12];
#pragma unroll
            for (int u = 0; u < 12; ++u) { av[u] = *(const bf16x8*)(ap + 32 * u); b0[u] = *(const bf16x8*)(b0p + 32 * u); b1[u] = *(const bf16x8*)(b1p + 32 * u); }
#pragma unroll
            for (int u = 0; u < 12; ++u) { acc0 = mfma16(b0[u], av[u], acc0); acc1 = mfma16(b1[u], av[u], acc1); }
        } else
        for (int k = 0; k < kw; k += 128) {
            bf16x8 av[4], b0[4], b1[4];
#pragma unroll
            for (int u = 0; u < 4; ++u) { av[u] = *(const bf16x8*)(ap + k + 32 * u); b0[u] = *(const bf16x8*)(b0p + k + 32 * u); b1[u] = *(const bf16x8*)(b1p + k + 32 * u); }
#pragma unroll
            for (int u = 0; u < 4; ++u) { acc0 = mfma16(b0[u], av[u], acc0); acc1 = mfma16(b1[u], av[u], acc1); }
        }
        red[(wave * 2 + 0) * 64 + lane] = acc0; red[(wave * 2 + 1) * 64 + lane] = acc1;
        __syncthreads();
        if (wave == 0) {
#pragma unroll
            for (int w = 1; w < 8; ++w) { acc0 += red[(w * 2 + 0) * 64 + lane]; acc1 += red[(w * 2 + 1) * 64 + lane]; }
            f(acc0, acc1, rg * 16 + fr, ccol, q);
        }
        __syncthreads();
    }
}
template <class F>
__device__ __forceinline__ void small_gemm128(LAS unsigned char* L, const bf16_t* A, const bf16_t* Bt, int ncg, int bid, int G, int wave, int lane, const F& f) {
    constexpr int K = 1024;
    const int fr = lane & 15, q = lane >> 4, rh = wave & 1, kq = wave >> 1;
    LAS f32x4* red = (LAS f32x4*)L;
    for (int task = bid; task < ncg; task += G) {
        const int n0 = (task >> 3) * 256 + (task & 7) * 16;
        const bf16_t* ap = A + (size_t)(rh * 64 + fr) * K + kq * 256 + 8 * q;
        const bf16_t* b0p = Bt + (size_t)(n0 + fr) * K + kq * 256 + 8 * q; const bf16_t* b1p = b0p + (size_t)128 * K;
        f32x4 acc[4][2];
#pragma unroll
        for (int fi = 0; fi < 4; ++fi) { acc[fi][0] = (f32x4){0.f, 0.f, 0.f, 0.f}; acc[fi][1] = acc[fi][0]; }
#pragma unroll
        for (int kb = 0; kb < 2; ++kb) {
            bf16x8 av[4][4], b0[4], b1[4];
#pragma unroll
            for (int u = 0; u < 4; ++u) { const int k = kb * 128 + 32 * u; b0[u] = *(const bf16x8*)(b0p + k); b1[u] = *(const bf16x8*)(b1p + k);
#pragma unroll
                for (int fi = 0; fi < 4; ++fi) av[fi][u] = *(const bf16x8*)(ap + (size_t)fi * 16 * K + k); }
#pragma unroll
            for (int u = 0; u < 4; ++u)
#pragma unroll
                for (int fi = 0; fi < 4; ++fi) { acc[fi][0] = mfma16(b0[u], av[fi][u], acc[fi][0]); acc[fi][1] = mfma16(b1[u], av[fi][u], acc[fi][1]); }
        }
#pragma unroll
        for (int fi = 0; fi < 4; ++fi) { red[((((rh * 4 + kq) * 4 + fi) * 2) + 0) * 64 + lane] = acc[fi][0]; red[((((rh * 4 + kq) * 4 + fi) * 2) + 1) * 64 + lane] = acc[fi][1]; }
        __syncthreads();
        {
            const int erh = wave >> 2, efi = wave & 3;
            f32x4 s0 = (f32x4){0.f, 0.f, 0.f, 0.f}, s1 = s0;
#pragma unroll
            for (int k2 = 0; k2 < 4; ++k2) { s0 += red[((((erh * 4 + k2) * 4 + efi) * 2) + 0) * 64 + lane]; s1 += red[((((erh * 4 + k2) * 4 + efi) * 2) + 1) * 64 + lane]; }
            f(s0, s1, (erh * 4 + efi) * 16 + fr, task * 16, q);
        }
        __syncthreads();
    }
}
__device__ __forceinline__ float sample_rstd(const float* ssqs, int row, int q) {
    const f32x4 p0 = *(const f32x4*)(ssqs + row * 32 + 8 * q), p1 = *(const f32x4*)(ssqs + row * 32 + 8 * q + 4);
    float s = ((p0[0] + p0[1]) + (p0[2] + p0[3])) + ((p1[0] + p1[1]) + (p1[2] + p1[3]));
    s += __shfl_xor(s, 16); s += __shfl_xor(s, 32);
    return 1.0f / sqrtf(s * (1.0f / 1024.0f) + 1e-6f);
}
struct SEpiScale {
    float* O; const float* ssqs;
    __device__ __forceinline__ void operator()(f32x4 a0, f32x4 a1, int row, int n0, int q) const {
        const float r = sample_rstd(ssqs, row, q);
        *(f32x4*)(O + (size_t)row * 1792 + n0 + 4 * q) = a0 * r; *(f32x4*)(O + (size_t)row * 1792 + n0 + 16 + 4 * q) = a1 * r;
    }
};
struct SEpiResid {
    const float* xin; float* xout; bf16_t* xb; float* ssqs;
    __device__ __forceinline__ void operator()(f32x4 a0, f32x4 a1, int row, int n0, int q) const {
        const size_t o0 = (size_t)row * 1024 + n0 + 4 * q, o1 = o0 + 16;
        const f32x4 x0 = *(const f32x4*)(xin + o0) + a0, x1 = *(const f32x4*)(xin + o1) + a1;
        *(f32x4*)(xout + o0) = x0; *(f32x4*)(xout + o1) = x1;
        u32x2 w; w.x = pk2(x0[0], x0[1]); w.y = pk2(x0[2], x0[3]); *(u32x2*)(xb + o0) = w;
        w.x = pk2(x1[0], x1[1]); w.y = pk2(x1[2], x1[3]); *(u32x2*)(xb + o1) = w;
        float s = ((x0[0] * x0[0] + x0[1] * x0[1]) + (x0[2] * x0[2] + x0[3] * x0[3])) + ((x1[0] * x1[0] + x1[1] * x1[1]) + (x1[2] * x1[2] + x1[3] * x1[3]));
        s += __shfl_xor(s, 16); s += __shfl_xor(s, 32);
        if (q == 0) ssqs[row * 32 + (n0 >> 5)] = s;
    }
};
struct SEpiFfn {
    const float* st; const float* cw; const float* cb; float* sfc; bf16_t* G; const float* ssqs;
    __device__ __forceinline__ void operator()(f32x4 a0, f32x4 a1, int row, int n0, int q) const {
        const float r = sample_rstd(ssqs, row, q);
        const int c = n0 + 4 * q;
        f32x4 u[2] = { a0 * r, a1 * r }; f32x4 v[2];
#pragma unroll
        for (int hf = 0; hf < 2; ++hf) {
            const int cc = c + hf * DFF;
            const f32x4 s0 = __builtin_nontemporal_load((const f32x4*)(st + ((size_t)row * 2 + 0) * 6144 + cc)), s1 = __builtin_nontemporal_load((const f32x4*)(st + ((size_t)row * 2 + 1) * 6144 + cc));
            const f32x4 w0 = *(const f32x4*)(cw + cc), w1 = *(const f32x4*)(cw + 6144 + cc), w2 = *(const f32x4*)(cw + 2 * 6144 + cc), bb = *(const f32x4*)(cb + cc);
            v[hf] = s0 * w0 + s1 * w1 + u[hf] * w2 + bb;
            *(f32x4*)(sfc + ((size_t)row * 2 + 0) * 6144 + cc) = s1; *(f32x4*)(sfc + ((size_t)row * 2 + 1) * 6144 + cc) = u[hf];
        }
        u32x2 w; w.x = pk2(gelu_tanh(v[0][0]) * v[1][0], gelu_tanh(v[0][1]) * v[1][1]); w.y = pk2(gelu_tanh(v[0][2]) * v[1][2], gelu_tanh(v[0][3]) * v[1][3]);
        *(u32x2*)(G + (size_t)(MP + row) * DFF + c) = w;
    }
};

__device__ __forceinline__ void unpack8(const u32x4 w, float (&v)[8]) { v[0] = bflo(w.x); v[1] = bfhi(w.x); v[2] = bflo(w.y); v[3] = bfhi(w.y); v[4] = bflo(w.z); v[5] = bfhi(w.z); v[6] = bflo(w.w); v[7] = bfhi(w.w); }
__device__ __forceinline__ void rglru_item(const Args& a, LAS unsigned char* L, int l, int mode, int item, bool sample, const int tid) {
    const int lane = tid & 63, wave = tid >> 6;
    unsigned char* ws = a.ws_();
    LAS float* xs = (LAS float*)L;
    LAS float* Bx = xs;
    LAS float* xcf = (LAS float*)(L + 33792);
    LAS float* Aa = (LAS float*)(L + 33792 + 32768);
    LAS bf16_t* xcb = (LAS bf16_t*)(L + 33792 + 65536);
    LAS bf16_t* WT = xcb + 128 * 72;
    LAS float* seg = (LAS float*)(L + 33792 + 65536 + 36864);
    LAS float* hin = seg + 1024;
    LAS float* cst = hin + 64;
    int n, c = 0, b = 0;
    if (sample) n = item; else { n = item % 12; const int rest = item / 12; c = rest & 31; b = rest >> 5; }
    const int ch0 = n * 64, t0 = c * 128, row0 = b * SEQ + t0;
    const bf16_t* UIN = (const bf16_t*)(ws + WS_UIN);
    const float* UINS = (const float*)(ws + WS_UINS);
    const float* cw = a.in_(I_RCW) + (size_t)l * 4 * DRNN + ch0; const float* cbias = a.in_(I_RCB) + l * DRNN + ch0;
    {
        const bf16_t* wg = (const bf16_t*)(ws + WS_WG) + (size_t)(l * 12 + n) * 8192;
#pragma unroll
        for (int i = 0; i < 2; ++i) { const int idx = tid + 512 * i, g = idx >> 9, j = (idx >> 3) & 63, c8 = idx & 7;
            *(LAS u32x4*)(WT + g * 64 * 72 + j * 72 + 8 * c8) = *(const u32x4*)(wg + g * 4096 + j * 64 + 8 * c8); }
    }
    if (tid < 64) { cst[tid] = -log1pf(expf(-a.in_(I_LRU)[l * DRNN + ch0 + tid])); cst[64 + tid] = a.in_(I_BGX)[l * DRNN + ch0 + tid]; cst[128 + tid] = a.in_(I_BGA)[l * DRNN + ch0 + tid]; }
    if (!sample) {
        const int cg8 = tid & 7, tq = tid >> 3, tk = 2 * tq;
        float wv[4][8], wbv[8];
#pragma unroll
        for (int jx = 0; jx < 4; ++jx) { const f32x4 p0 = *(const f32x4*)(cw + jx * DRNN + 8 * cg8), p1 = *(const f32x4*)(cw + jx * DRNN + 8 * cg8 + 4);
#pragma unroll
            for (int e2 = 0; e2 < 4; ++e2) { wv[jx][e2] = p0[e2]; wv[jx][4 + e2] = p1[e2]; } }
        { const f32x4 p0 = *(const f32x4*)(cbias + 8 * cg8), p1 = *(const f32x4*)(cbias + 8 * cg8 + 4);
#pragma unroll
          for (int e2 = 0; e2 < 4; ++e2) { wbv[e2] = p0[e2]; wbv[4 + e2] = p1[e2]; } }
        float xr[5][8];
#pragma unroll
        for (int r = 0; r < 5; ++r) { const int t = t0 + tk - 3 + r;
            if (t >= 0) unpack8(*(const u32x4*)(UIN + (size_t)(b * SEQ + t) * 1792 + 768 + ch0 + 8 * cg8), xr[r]);
            else {
#pragma unroll
                for (int e2 = 0; e2 < 8; ++e2) xr[r][e2] = 0.f; } }
#pragma unroll
        for (int tt = 0; tt < 2; ++tt) {
            float xc[8];
#pragma unroll
            for (int e2 = 0; e2 < 8; ++e2) xc[e2] = wbv[e2] + xr[tt][e2] * wv[0][e2] + xr[tt + 1][e2] * wv[1][e2] + xr[tt + 2][e2] * wv[2][e2] + xr[tt + 3][e2] * wv[3][e2];
            *(LAS f32x4*)(xcf + (tk + tt) * 64 + 8 * cg8) = (f32x4){xc[0], xc[1], xc[2], xc[3]}; *(LAS f32x4*)(xcf + (tk + tt) * 64 + 8 * cg8 + 4) = (f32x4){xc[4], xc[5], xc[6], xc[7]};
            u32x4 w; w.x = pk2(xc[0], xc[1]); w.y = pk2(xc[2], xc[3]); w.z = pk2(xc[4], xc[5]); w.w = pk2(xc[6], xc[7]);
            *(LAS u32x4*)(xcb + (tk + tt) * 72 + 8 * cg8) = w;
        }
        if (c == 31 && tq >= 62) {
            float* o = a.out_() + O_PRC + ((size_t)(l * 4 + b) * 3) * DRNN + ch0 + 8 * cg8;
#pragma unroll
            for (int tt = 0; tt < 2; ++tt) { const int jx = tk + tt - 125;
                if (jx >= 0) { *(f32x4*)(o + (size_t)jx * DRNN) = (f32x4){xr[3 + tt][0], xr[3 + tt][1], xr[3 + tt][2], xr[3 + tt][3]}; *(f32x4*)(o + (size_t)jx * DRNN + 4) = (f32x4){xr[3 + tt][4], xr[3 + tt][5], xr[3 + tt][6], xr[3 + tt][7]}; } }
        }
    } else {
        for (int idx = tid; idx < 128 * 64; idx += 512) { const int bb = idx >> 6, ch = idx & 63;
            const float* stp = a.in_(I_SRC) + ((size_t)(l * 128 + bb) * 3) * DRNN + ch0 + ch;
            const float s0 = stp[0], s1 = stp[DRNN], s2 = stp[2 * DRNN], xn = UINS[(size_t)bb * 1792 + 768 + ch0 + ch];
            const float xc = cbias[ch] + s0 * cw[ch] + s1 * cw[DRNN + ch] + s2 * cw[2 * DRNN + ch] + xn * cw[3 * DRNN + ch];
            xcf[idx] = xc; xcb[bb * 72 + ch] = (bf16_t)f2bf(xc);
            float* o = a.out_() + O_SRC + ((size_t)(l * 128 + bb) * 3) * DRNN + ch0 + ch; o[0] = s1; o[DRNN] = s2; o[2 * DRNN] = xn; }
    }
    __syncthreads();
    {
        const int fr = lane & 15, q = lane >> 4, tok = wave * 16 + fr;
        const bf16x8 a0 = *(const LAS bf16x8*)(xcb + tok * 72 + 8 * q), a1 = *(const LAS bf16x8*)(xcb + tok * 72 + 32 + 8 * q);
        float* DA = (float*)(ws + WS_U); float* DB = DA + (size_t)MP * DRNN;
#pragma unroll
        for (int jt = 0; jt < 4; ++jt) {
            const LAS bf16_t* wp = WT + (jt * 16 + fr) * 72 + 8 * q;
            f32x4 gx = (f32x4){0.f, 0.f, 0.f, 0.f}, ga = gx;
            gx = mfma16(*(const LAS bf16x8*)(wp), a0, gx); gx = mfma16(*(const LAS bf16x8*)(wp + 32), a1, gx);
            ga = mfma16(*(const LAS bf16x8*)(wp + 64 * 72), a0, ga); ga = mfma16(*(const LAS bf16x8*)(wp + 64 * 72 + 32), a1, ga);
            f32x4 av4, bv4;
#pragma unroll
            for (int i = 0; i < 4; ++i) { const int ch = jt * 16 + 4 * q + i;
                const float sgx = sigmoidf_(gx[i] + cst[64 + ch]), sga = sigmoidf_(ga[i] + cst[128 + ch]);
                const float log_a = 8.0f * sga * cst[ch]; const float av = __expf(log_a);
                const float bxv = sqrtf(fmaxf(1.0f - av * av, 0.f)) * sgx * xcf[tok * 64 + ch];
                av4[i] = av; bv4[i] = bxv; }
            *(LAS f32x4*)(Aa + tok * 64 + jt * 16 + 4 * q) = av4; *(LAS f32x4*)(Bx + tok * 64 + jt * 16 + 4 * q) = bv4;
            if (!sample) { __builtin_nontemporal_store(av4, (f32x4*)(DA + (size_t)(row0 + tok) * DRNN + ch0 + jt * 16 + 4 * q)); __builtin_nontemporal_store(bv4, (f32x4*)(DB + (size_t)(row0 + tok) * DRNN + ch0 + jt * 16 + 4 * q)); }
        }
    }
    __syncthreads();
    if (sample) {
        for (int idx = tid; idx < 128 * 64; idx += 512) { const int bb = idx >> 6, ch = idx & 63;
            const float h0 = a.in_(I_SH)[(size_t)(l * 128 + bb) * DRNN + ch0 + ch];
            const float h = Aa[idx] * h0 + Bx[idx];
            const float gate = UINS[(size_t)bb * 1792 + ch0 + ch];
            ((bf16_t*)(ws + WS_MIX))[(size_t)(MP + bb) * DM + ch0 + ch] = (bf16_t)f2bf(h * gelu_tanh(gate));
            a.out_()[O_SH + (size_t)(l * 128 + bb) * DRNN + ch0 + ch] = h; }
    } else {
        const int ch = tid & 63, sg = tid >> 6;
        { float Ap = 1.f, Bp = 0.f;
#pragma unroll 4
          for (int t = sg * 16; t < sg * 16 + 16; ++t) { const float av = Aa[t * 64 + ch], bv = Bx[t * 64 + ch]; Bp = av * Bp + bv; Ap *= av; }
          seg[sg * 64 + ch] = Ap; seg[512 + sg * 64 + ch] = Bp; }
        __syncthreads();
        float* CA = (float*)(ws + WS_CARA); float* CB = (float*)(ws + WS_CARB);
        if (mode == 0) {
            if (sg == 0) { float A = 1.f, B = 0.f;
#pragma unroll
                for (int s = 0; s < 8; ++s) { const float sa = seg[s * 64 + ch]; B = sa * B + seg[512 + s * 64 + ch]; A *= sa; }
                CA[(size_t)(b * 32 + c) * DRNN + ch0 + ch] = A; CB[(size_t)(b * 32 + c) * DRNN + ch0 + ch] = B; }
        } else {
            if (tid < 64) { float h = 0.f; for (int cc = 0; cc < c; ++cc) h = CA[(size_t)(b * 32 + cc) * DRNN + ch0 + ch] * h + CB[(size_t)(b * 32 + cc) * DRNN + ch0 + ch]; hin[ch] = h; }
            __syncthreads();
            float h = hin[ch];
            for (int s = 0; s < sg; ++s) h = seg[s * 64 + ch] * h + seg[512 + s * 64 + ch];
            bf16_t* MIX = (bf16_t*)(ws + WS_MIX);
#pragma unroll 4
            for (int t = sg * 16; t < sg * 16 + 16; ++t) {
                h = Aa[t * 64 + ch] * h + Bx[t * 64 + ch];
                const float gate = bf2f(UIN[(size_t)(row0 + t) * 1792 + ch0 + ch]);
                MIX[(size_t)(row0 + t) * DM + ch0 + ch] = (bf16_t)f2bf(h * gelu_tanh(gate)); }
            if (c == 31 && sg == 7) a.out_()[O_PH + (size_t)(l * 4 + b) * DRNN + ch0 + ch] = h;
        }
    }
    __syncthreads();
}

__device__ __forceinline__ void rglru_scan_item2(const Args& a, LAS unsigned char* L, int l, int item0, const int tid) {
    unsigned char* ws = a.ws_();
    const int hfi = tid >> 8, t256 = tid & 255, cq = t256 & 15, sg = t256 >> 4;
    LAS f32x4* seg = (LAS f32x4*)L + hfi * 1024;
    LAS f32x4* par = seg + 512;
    const int item = item0 + hfi;
    const int n = item % 12, rest = item / 12, c = rest & 31, b = rest >> 5;
    const int ch0 = n * 64 + 4 * cq, row0 = b * SEQ + c * 128 + sg * 8;
    const float* DA = (const float*)(ws + WS_U); const float* DB = DA + (size_t)MP * DRNN;
    const float* CA = (const float*)(ws + WS_CARA); const float* CB = (const float*)(ws + WS_CARB);
    f32x4 av[8], bv[8];
#pragma unroll
    for (int t = 0; t < 8; ++t) { const size_t o = (size_t)(row0 + t) * DRNN + ch0; av[t] = __builtin_nontemporal_load((const f32x4*)(DA + o)); bv[t] = __builtin_nontemporal_load((const f32x4*)(DB + o)); }
    const f32x4 one = (f32x4){1.f, 1.f, 1.f, 1.f}, zero = (f32x4){0.f, 0.f, 0.f, 0.f};
    f32x4 pa = one, pb = zero;
#pragma unroll
    for (int k = 0; k < 2; ++k) { const int cc = sg * 2 + k; if (cc < c) { const size_t o = (size_t)(b * 32 + cc) * DRNN + ch0; const f32x4 xa = *(const f32x4*)(CA + o), xb = *(const f32x4*)(CB + o); pb = xa * pb + xb; pa *= xa; } }
    f32x4 Ap = one, Bp = zero;
#pragma unroll
    for (int t = 0; t < 8; ++t) { Bp = av[t] * Bp + bv[t]; Ap *= av[t]; }
    seg[sg * 16 + cq] = Ap; seg[256 + sg * 16 + cq] = Bp; par[sg * 16 + cq] = pa; par[256 + sg * 16 + cq] = pb;
    __syncthreads();
    f32x4 h = zero;
#pragma unroll
    for (int s = 0; s < 16; ++s) h = par[s * 16 + cq] * h + par[256 + s * 16 + cq];
    for (int s = 0; s < sg; ++s) h = seg[s * 16 + cq] * h + seg[256 + s * 16 + cq];
    const bf16_t* UIN = (const bf16_t*)(ws + WS_UIN); bf16_t* MIX = (bf16_t*)(ws + WS_MIX);
#pragma unroll
    for (int t = 0; t < 8; ++t) {
        h = av[t] * h + bv[t];
        const size_t r = (size_t)(row0 + t);
        const u32x2 gw2 = __builtin_nontemporal_load((const u32x2*)(UIN + r * 1792 + ch0));
        u32x2 w; w.x = pk2(h[0] * gelu_tanh(bflo(gw2.x)), h[1] * gelu_tanh(bfhi(gw2.x))); w.y = pk2(h[2] * gelu_tanh(bflo(gw2.y)), h[3] * gelu_tanh(bfhi(gw2.y)));
        *(u32x2*)(MIX + r * DM + ch0) = w; }
    if (c == 31 && sg == 15) *(f32x4*)(a.out_() + O_PH + (size_t)(l * 4 + b) * DRNN + ch0) = h;
    __syncthreads();
}

template <int NT, bool SWA>
__device__ __forceinline__ void attn_core(const LAS bf16_t* Ks, const LAS bf16_t* Vt, int VS, bf16x8 q0, bf16x8 q1, int tile0, int qi, bool first_block, float sink,
                                          f32x4 (&o)[4], float& den, int fr, int q) {
    f32x4 s[NT];
#pragma unroll
    for (int j = 0; j < NT; ++j) {
        const LAS bf16_t* kp = Ks + ((tile0 + j) * 16 + fr) * 72 + 8 * q;
        f32x4 z = (f32x4){0.f, 0.f, 0.f, 0.f};
        z = mfma16(*(const LAS bf16x8*)kp, q0, z); z = mfma16(*(const LAS bf16x8*)(kp + 32), q1, z);
        s[j] = z;
        if (j & 1) asm volatile("" ::: "memory");
    }
    float mx = -1e30f;
    const int lo = (first_block && qi < 128) ? 128 : qi, hi = qi + 128;
#pragma unroll
    for (int j = 0; j < NT; ++j)
#pragma unroll
        for (int i = 0; i < 4; ++i) {
            if (SWA) { const int jj = (tile0 + j) * 16 + 4 * q + i; if (jj < lo || jj > hi) s[j][i] = -1e30f; }
            mx = fmaxf(mx, s[j][i]);
        }
    mx = fmaxf(mx, __shfl_xor(mx, 16)); mx = fmaxf(mx, __shfl_xor(mx, 32));
    if (SWA) mx = fmaxf(mx, sink);
    float sum = 0.f;
#pragma unroll
    for (int j = 0; j < NT; ++j)
#pragma unroll
        for (int i = 0; i < 4; ++i) { const float p = __expf(s[j][i] - mx); s[j][i] = p; sum += p; }
    sum += __shfl_xor(sum, 16); sum += __shfl_xor(sum, 32);
    if (SWA) sum += __expf(sink - mx);
    den = sum;
#pragma unroll
    for (int db = 0; db < 4; ++db) o[db] = (f32x4){0.f, 0.f, 0.f, 0.f};
#pragma unroll
    for (int t = 0; t < NT / 2; ++t) {
        u32x4 pw; pw.x = pk2(s[2 * t][0], s[2 * t][1]); pw.y = pk2(s[2 * t][2], s[2 * t][3]); pw.z = pk2(s[2 * t + 1][0], s[2 * t + 1][1]); pw.w = pk2(s[2 * t + 1][2], s[2 * t + 1][3]);
        const bf16x8 pf = __builtin_bit_cast(bf16x8, pw);
#pragma unroll
        for (int db = 0; db < 4; ++db) {
            const LAS bf16_t* vp = Vt + (db * 16 + fr) * VS + (tile0 + 2 * t) * 16 + 4 * q;
            const u32x2 v0 = *(const LAS u32x2*)vp, v1 = *(const LAS u32x2*)(vp + 16);
            u32x4 vw; vw.x = v0.x; vw.y = v0.y; vw.z = v1.x; vw.w = v1.y;
            o[db] = mfma16(__builtin_bit_cast(bf16x8, vw), pf, o[db]);
        }
        asm volatile("" ::: "memory");
    }
}
__device__ __forceinline__ void store_attn_out(bf16_t* dst, const f32x4 (&o)[4], float den, int q) {
    const float inv = 1.0f / den;
#pragma unroll
    for (int db = 0; db < 4; ++db) { u32x2 w; w.x = pk2(o[db][0] * inv, o[db][1] * inv); w.y = pk2(o[db][2] * inv, o[db][3] * inv); *(u32x2*)(dst + db * 16 + 4 * q) = w; }
}

__device__ __forceinline__ void memattn_prompt_item(const Args& a, LAS unsigned char* L, int l, int item, const int tid) {
    const int lane = tid & 63, wave = tid >> 6, fr = lane & 15, q = lane >> 4;
    unsigned char* ws = a.ws_();
    const int tp = item & 15, bh = item >> 4, h = bh & 3, b = bh >> 2;
    LAS bf16_t* Ks = (LAS bf16_t*)L; LAS bf16_t* Vt = (LAS bf16_t*)(L + 36864);
    const bf16_t* mk = (const bf16_t*)(ws + WS_MK) + (size_t)((l * 4 + b) * 4 + h) * 256 * 64;
    const bf16_t* mv = (const bf16_t*)(ws + WS_MVT) + (size_t)((l * 4 + b) * 4 + h) * 64 * 256;
#pragma unroll
    for (int i = 0; i < 4; ++i) { const int idx = tid + 512 * i;
        { const int row = idx >> 3, cc = idx & 7; *(LAS u32x4*)(Ks + row * 72 + cc * 8) = *(const u32x4*)(mk + row * 64 + cc * 8); }
        { const int row = idx >> 5, cc = idx & 31; *(LAS u32x4*)(Vt + row * 264 + cc * 8) = *(const u32x4*)(mv + row * 256 + cc * 8); } }
    __syncthreads();
    const int ld = (l < 2) ? 1792 : 1536, qoff = (l < 2) ? 1536 : 768;
#pragma unroll 1
    for (int tt = 0; tt < 2; ++tt) {
    const int tile = 2 * tp + tt;
    const int row = b * SEQ + tile * 128 + wave * 16 + fr;
    const bf16_t* qp = (const bf16_t*)(ws + WS_UIN) + (size_t)row * ld + qoff + h * 64 + 8 * q;
    float x1[8], x2[8]; unpack8(__builtin_nontemporal_load((const u32x4*)qp), x1); unpack8(__builtin_nontemporal_load((const u32x4*)(qp + 32)), x2);
    float ss = 0.f;
#pragma unroll
    for (int e = 0; e < 8; ++e) ss += x1[e] * x1[e] + x2[e] * x2[e];
    ss += __shfl_xor(ss, 16); ss += __shfl_xor(ss, 32);
    const float r = 0.125f * __builtin_amdgcn_rsqf(ss * (1.0f / 64.0f) + 1e-6f);
    const float* g = a.in_(I_MQNG) + l * 64 + 8 * q;
    u32x4 w0, w1;
    w0.x = pk2(x1[0] * r * g[0], x1[1] * r * g[1]); w0.y = pk2(x1[2] * r * g[2], x1[3] * r * g[3]); w0.z = pk2(x1[4] * r * g[4], x1[5] * r * g[5]); w0.w = pk2(x1[6] * r * g[6], x1[7] * r * g[7]);
    w1.x = pk2(x2[0] * r * g[32], x2[1] * r * g[33]); w1.y = pk2(x2[2] * r * g[34], x2[3] * r * g[35]); w1.z = pk2(x2[4] * r * g[36], x2[5] * r * g[37]); w1.w = pk2(x2[6] * r * g[38], x2[7] * r * g[39]);
    f32x4 o[4]; float den;
    attn_core<16, false>(Ks, Vt, 264, __builtin_bit_cast(bf16x8, w0), __builtin_bit_cast(bf16x8, w1), 0, 0, false, 0.f, o, den, fr, q);
    store_attn_out((bf16_t*)(ws + WS_MIX) + (size_t)row * DM + 768 + h * 64, o, den, q);
    }
    __syncthreads();
}

__device__ __forceinline__ void swa_prompt_item(const Args& a, LAS unsigned char* L, int j, int item, bool write_state, const int tid) {
    const int lane = tid & 63, wave = __builtin_amdgcn_readfirstlane(tid >> 6), fr = lane & 15, q = lane >> 4;
    unsigned char* ws = a.ws_();
    const int kvh = item & 3, qb = (item >> 2) & 31, b = item >> 7;
    LAS bf16_t* Ks = (LAS bf16_t*)L; LAS bf16_t* Vt = (LAS bf16_t*)(L + 36864);
    const bf16_t* UIN = (const bf16_t*)(ws + WS_UIN);
    const float* rc = (const float*)(ws + WS_ROPEC); const float* rs = (const float*)(ws + WS_ROPES);
    const bool wst = write_state && qb == 31;
    const int tokq = qb * 128 + wave * 16 + fr, row = b * SEQ + tokq;
    float qc[8], qs[8];
    { const f32x4 c0 = *(const f32x4*)(rc + tokq * 32 + 8 * q), c1 = *(const f32x4*)(rc + tokq * 32 + 8 * q + 4), s0 = *(const f32x4*)(rs + tokq * 32 + 8 * q), s1 = *(const f32x4*)(rs + tokq * 32 + 8 * q + 4);
#pragma unroll
      for (int e2 = 0; e2 < 4; ++e2) { qc[e2] = c0[e2]; qc[4 + e2] = c1[e2]; qs[e2] = s0[e2]; qs[4 + e2] = s1[e2]; } }
    u32x4 qraw[3][2];
#pragma unroll
    for (int g = 0; g < 3; ++g) { const bf16_t* qp = UIN + (size_t)row * 1536 + (kvh * 3 + g) * 64 + 8 * q; qraw[g][0] = __builtin_nontemporal_load((const u32x4*)qp); qraw[g][1] = __builtin_nontemporal_load((const u32x4*)(qp + 32)); }
#pragma unroll
    for (int rep = 0; rep < 2; ++rep) {
        const int task = tid + 512 * rep, jj = task >> 2, dg = task & 3, tok = qb * 128 - 128 + jj;
        float x1[8], x2[8];
        if (tok >= 0) { const bf16_t* kp = UIN + (size_t)(b * SEQ + tok) * 1536 + 1024 + kvh * 64 + 8 * dg; unpack8(*(const u32x4*)kp, x1); unpack8(*(const u32x4*)(kp + 32), x2); }
        else {
#pragma unroll
            for (int e = 0; e < 8; ++e) { x1[e] = 0.f; x2[e] = 0.f; } }
        float ss = 0.f;
#pragma unroll
        for (int e = 0; e < 8; ++e) ss += x1[e] * x1[e] + x2[e] * x2[e];
        ss += __shfl_xor(ss, 1); ss += __shfl_xor(ss, 2);
        const float r = __builtin_amdgcn_rsqf(ss * (1.0f / 64.0f) + 1e-6f);
        const float* kg = a.in_(I_KNG) + 8 * dg; const int tp = tok >= 0 ? tok : 0;
        float o1[8], o2[8];
#pragma unroll
        for (int e = 0; e < 8; ++e) { const float c = rc[tp * 32 + 8 * dg + e], s = rs[tp * 32 + 8 * dg + e]; const float y1 = x1[e] * r * kg[e], y2 = x2[e] * r * kg[32 + e];
            o1[e] = y1 * c - y2 * s; o2[e] = y2 * c + y1 * s; }
        u32x4 w; w.x = pk2(o1[0], o1[1]); w.y = pk2(o1[2], o1[3]); w.z = pk2(o1[4], o1[5]); w.w = pk2(o1[6], o1[7]); *(LAS u32x4*)(Ks + jj * 72 + 8 * dg) = w;
        w.x = pk2(o2[0], o2[1]); w.y = pk2(o2[2], o2[3]); w.z = pk2(o2[4], o2[5]); w.w = pk2(o2[6], o2[7]); *(LAS u32x4*)(Ks + jj * 72 + 32 + 8 * dg) = w;
        if (wst && jj >= 128) { float* o = a.out_() + O_PK + ((size_t)(b * 128 + jj - 128) * 4 + kvh) * 64 + 8 * dg;
            *(f32x4*)o = (f32x4){o1[0], o1[1], o1[2], o1[3]}; *(f32x4*)(o + 4) = (f32x4){o1[4], o1[5], o1[6], o1[7]};
            *(f32x4*)(o + 32) = (f32x4){o2[0], o2[1], o2[2], o2[3]}; *(f32x4*)(o + 36) = (f32x4){o2[4], o2[5], o2[6], o2[7]}; }
    }
    {
        const int jj = tid & 255, hf = tid >> 8, tok = qb * 128 - 128 + jj;
#pragma unroll
        for (int c8 = 0; c8 < 4; ++c8) {
            float v[8];
            if (tok >= 0) unpack8(*(const u32x4*)(UIN + (size_t)(b * SEQ + tok) * 1536 + 1280 + kvh * 64 + hf * 32 + c8 * 8), v);
            else {
#pragma unroll
                for (int e = 0; e < 8; ++e) v[e] = 0.f; }
#pragma unroll
            for (int e = 0; e < 8; ++e) Vt[(hf * 32 + c8 * 8 + e) * 264 + jj] = (bf16_t)f2bf(v[e]);
            if (wst && jj >= 128) { float* o = a.out_() + O_PV + ((size_t)(b * 128 + jj - 128) * 4 + kvh) * 64 + hf * 32 + c8 * 8;
                *(f32x4*)o = (f32x4){v[0], v[1], v[2], v[3]}; *(f32x4*)(o + 4) = (f32x4){v[4], v[5], v[6], v[7]}; }
        }
    }
    __syncthreads();
#pragma unroll
    for (int g = 0; g < 3; ++g) {
        const int hq = kvh * 3 + g;
        float x1[8], x2[8]; unpack8(qraw[g][0], x1); unpack8(qraw[g][1], x2);
        float ss = 0.f;
#pragma unroll
        for (int e = 0; e < 8; ++e) ss += x1[e] * x1[e] + x2[e] * x2[e];
        ss += __shfl_xor(ss, 16); ss += __shfl_xor(ss, 32);
        const float r = __builtin_amdgcn_rsqf(ss * (1.0f / 64.0f) + 1e-6f);
        const float* qg = a.in_(I_QNG) + j * 64 + 8 * q;
        float o1[8], o2[8];
#pragma unroll
        for (int e = 0; e < 8; ++e) { const float c = qc[e], s = qs[e]; const float y1 = x1[e] * r * qg[e], y2 = x2[e] * r * qg[32 + e];
            o1[e] = (y1 * c - y2 * s) * 0.125f; o2[e] = (y2 * c + y1 * s) * 0.125f; }
        u32x4 w0, w1;
        w0.x = pk2(o1[0], o1[1]); w0.y = pk2(o1[2], o1[3]); w0.z = pk2(o1[4], o1[5]); w0.w = pk2(o1[6], o1[7]);
        w1.x = pk2(o2[0], o2[1]); w1.y = pk2(o2[2], o2[3]); w1.z = pk2(o2[4], o2[5]); w1.w = pk2(o2[6], o2[7]);
        f32x4 o[4]; float den; const float sinkv = a.in_(I_SINK)[j * 12 + hq];
        attn_core<10, true>(Ks, Vt, 264, __builtin_bit_cast(bf16x8, w0), __builtin_bit_cast(bf16x8, w1), wave & ~1, wave * 16 + fr, qb == 0, sinkv, o, den, fr, q);
        store_attn_out((bf16_t*)(ws + WS_MIX) + (size_t)row * DM + hq * 64, o, den, q);
    }
    __syncthreads();
}

__device__ __forceinline__ void sample_attn_item(const Args& a, LAS unsigned char* L, int b, int NH, int G, int NC, const float* Kc, const float* Vc,
                                                 int qcol, const float* qg, bool swa, int j, bool write_state, int mixoff, const int tid) {
    const int lane = tid & 63, wave = tid >> 6;
    unsigned char* ws = a.ws_();
    LAS float* qs = (LAS float*)L;
    LAS float* sc = qs + 768;
    LAS float* knew = sc + 12 * 260;
    LAS float* vnew = knew + 256;
    LAS float* part = vnew + 256;
    const float* U = (const float*)(ws + WS_UINS) + (size_t)b * 1792;
    const float* rc = (const float*)(ws + WS_ROPEC) + 4096 * 32; const float* rs = (const float*)(ws + WS_ROPES) + 4096 * 32;
    for (int h = wave; h < NH; h += 8) {
        const float x = U[qcol + h * 64 + lane];
        const float ss = wave_sum(x * x); const float r = __builtin_amdgcn_rsqf(ss * (1.0f / 64.0f) + 1e-6f);
        float y = x * r * qg[lane];
        if (swa) { const float p = __shfl_xor(y, 32); const float c = rc[lane & 31], s = rs[lane & 31]; y = (lane < 32) ? (y * c - p * s) : (y * c + p * s); }
        qs[h * 64 + lane] = y * 0.125f;
    }
    if (swa && wave < 4) {
        const float x = U[1024 + wave * 64 + lane];
        const float ss = wave_sum(x * x); const float r = __builtin_amdgcn_rsqf(ss * (1.0f / 64.0f) + 1e-6f);
        float y = x * r * a.in_(I_KNG)[lane];
        const float p = __shfl_xor(y, 32); const float c = rc[lane & 31], s = rs[lane & 31]; y = (lane < 32) ? (y * c - p * s) : (y * c + p * s);
        const float v = U[1280 + wave * 64 + lane];
        knew[wave * 64 + lane] = y; vnew[wave * 64 + lane] = v;
        if (write_state) { a.out_()[O_SK + (size_t)b * 256 + wave * 64 + lane] = y; a.out_()[O_SV + (size_t)b * 256 + wave * 64 + lane] = v; }
    }
    __syncthreads();
    {
        const int kvh = lane >> 4, sub = lane & 15;
#pragma unroll 8
        for (int m = wave; m < NC; m += 8) {
            const f32x4 kv = __builtin_nontemporal_load((const f32x4*)(Kc + ((size_t)m * 4 + kvh) * 64 + 4 * sub));
#pragma unroll
            for (int g = 0; g < 3; ++g) if (g < G) {
                const int h = kvh * G + g; const f32x4 qv = *(const LAS f32x4*)(qs + h * 64 + 4 * sub);
                float d = (kv[0] * qv[0] + kv[1] * qv[1]) + (kv[2] * qv[2] + kv[3] * qv[3]);
                d += __shfl_xor(d, 1); d += __shfl_xor(d, 2); d += __shfl_xor(d, 4); d += __shfl_xor(d, 8);
                if (sub == 0) sc[h * 260 + m] = d;
            }
        }
        if (swa && wave == 0) {
            const f32x4 kv = *(const LAS f32x4*)(knew + kvh * 64 + 4 * sub);
#pragma unroll
            for (int g = 0; g < 3; ++g) {
                const int h = kvh * 3 + g; const f32x4 qv = *(const LAS f32x4*)(qs + h * 64 + 4 * sub);
                float d = (kv[0] * qv[0] + kv[1] * qv[1]) + (kv[2] * qv[2] + kv[3] * qv[3]);
                d += __shfl_xor(d, 1); d += __shfl_xor(d, 2); d += __shfl_xor(d, 4); d += __shfl_xor(d, 8);
                if (sub == 0) sc[h * 260 + NC] = d;
            }
        }
    }
    __syncthreads();
    const int NK = NC + (swa ? 1 : 0);
    for (int h = wave; h < NH; h += 8) {
        float mx = -1e30f;
        for (int m = lane; m < NK; m += 64) mx = fmaxf(mx, sc[h * 260 + m]);
        mx = wave_max(mx);
        float sk = 0.f; if (swa) { sk = a.in_(I_SINK)[j * 12 + h]; mx = fmaxf(mx, sk); }
        float sum = 0.f;
        for (int m = lane; m < NK; m += 64) { const float p = __expf(sc[h * 260 + m] - mx); sc[h * 260 + m] = p; sum += p; }
        sum = wave_sum(sum); if (swa) sum += __expf(sk - mx);
        const float inv = 1.0f / sum;
        for (int m = lane; m < NK; m += 64) sc[h * 260 + m] *= inv;
    }
    __syncthreads();
    {
        const int kvh = wave & 3, hf = wave >> 2, m0 = hf * (NC / 2), m1 = m0 + NC / 2, sub = lane & 15, ks = lane >> 4;
        f32x4 acc[3] = { (f32x4){0.f, 0.f, 0.f, 0.f}, (f32x4){0.f, 0.f, 0.f, 0.f}, (f32x4){0.f, 0.f, 0.f, 0.f} };
#pragma unroll 4
        for (int m = m0 + ks; m < m1; m += 4) { const f32x4 v = __builtin_nontemporal_load((const f32x4*)(Vc + ((size_t)m * 4 + kvh) * 64 + 4 * sub));
#pragma unroll
            for (int g = 0; g < 3; ++g) if (g < G) acc[g] += v * sc[(kvh * G + g) * 260 + m]; }
#pragma unroll
        for (int g = 0; g < 3; ++g) if (g < G) {
            f32x4 r = acc[g];
#pragma unroll
            for (int i = 0; i < 4; ++i) { r[i] += __shfl_xor(r[i], 16); r[i] += __shfl_xor(r[i], 32); }
            if (ks == 0) *(LAS f32x4*)(part + (hf * 12 + kvh * G + g) * 64 + 4 * sub) = r; }
    }
    __syncthreads();
    for (int idx = tid; idx < NH * 64; idx += 512) { const int h = idx >> 6, d = idx & 63;
        float o = part[h * 64 + d] + part[(12 + h) * 64 + d];
        if (swa) o += sc[h * 260 + NC] * vnew[(h / 3) * 64 + d];
        ((bf16_t*)(ws + WS_MIX))[(size_t)(MP + b) * DM + mixoff + idx] = (bf16_t)f2bf(o); }
    __syncthreads();
}

__device__ __forceinline__ void ffn_ew_item(const Args& a, int l, int item, const int tid) {
    unsigned char* ws = a.ws_();
    const int run = item / 3, third = item % 3, cgp = tid & 127, sub = tid >> 7;
    const int gt0 = run * 64 + sub * 16, b = gt0 >> 12, tin = gt0 & 4095, c0 = third * 1024 + cgp * 8;
    const bf16_t* U = (const bf16_t*)(ws + WS_U); bf16_t* G = (bf16_t*)(ws + WS_G);
    const float* cw = a.in_(I_FCW) + (size_t)l * 3 * 6144; const float* cb = a.in_(I_FCB) + (size_t)l * 6144;
    float w[2][3][8], bias[2][8];
#pragma unroll
    for (int hf = 0; hf < 2; ++hf) {
#pragma unroll
        for (int jx = 0; jx < 3; ++jx) { const f32x4 p0 = *(const f32x4*)(cw + jx * 6144 + hf * DFF + c0), p1 = *(const f32x4*)(cw + jx * 6144 + hf * DFF + c0 + 4);
#pragma unroll
            for (int e = 0; e < 4; ++e) { w[hf][jx][e] = p0[e]; w[hf][jx][4 + e] = p1[e]; } }
        const f32x4 p0 = *(const f32x4*)(cb + hf * DFF + c0), p1 = *(const f32x4*)(cb + hf * DFF + c0 + 4);
#pragma unroll
        for (int e = 0; e < 4; ++e) { bias[hf][e] = p0[e]; bias[hf][4 + e] = p1[e]; }
    }
    float p2[2][8], p1v[2][8];
#pragma unroll
    for (int hf = 0; hf < 2; ++hf) {
        if (tin != 0) { unpack8(*(const u32x4*)(U + (size_t)(gt0 - 2) * 6144 + hf * DFF + c0), p2[hf]); unpack8(*(const u32x4*)(U + (size_t)(gt0 - 1) * 6144 + hf * DFF + c0), p1v[hf]); }
        else {
#pragma unroll
            for (int e = 0; e < 8; ++e) { p2[hf][e] = 0.f; p1v[hf][e] = 0.f; } }
    }
#pragma unroll 2
    for (int t = 0; t < 16; ++t) {
        float cur[2][8], v[2][8];
#pragma unroll
        for (int hf = 0; hf < 2; ++hf) { unpack8(*(const u32x4*)(U + (size_t)(gt0 + t) * 6144 + hf * DFF + c0), cur[hf]);
#pragma unroll
            for (int e = 0; e < 8; ++e) { v[hf][e] = bias[hf][e] + p2[hf][e] * w[hf][0][e] + p1v[hf][e] * w[hf][1][e] + cur[hf][e] * w[hf][2][e]; p2[hf][e] = p1v[hf][e]; p1v[hf][e] = cur[hf][e]; } }
        u32x4 o; o.x = pk2(gelu_tanh(v[0][0]) * v[1][0], gelu_tanh(v[0][1]) * v[1][1]); o.y = pk2(gelu_tanh(v[0][2]) * v[1][2], gelu_tanh(v[0][3]) * v[1][3]);
        o.z = pk2(gelu_tanh(v[0][4]) * v[1][4], gelu_tanh(v[0][5]) * v[1][5]); o.w = pk2(gelu_tanh(v[0][6]) * v[1][6], gelu_tanh(v[0][7]) * v[1][7]);
        *(u32x4*)(G + (size_t)(gt0 + t) * DFF + c0) = o;
        if (tin + t >= 4094) { const int jx = tin + t - 4094;
#pragma unroll
            for (int hf = 0; hf < 2; ++hf) { float* op = a.out_() + O_PFC + ((size_t)(l * 4 + b) * 2 + jx) * 6144 + hf * DFF + c0;
                *(f32x4*)op = (f32x4){cur[hf][0], cur[hf][1], cur[hf][2], cur[hf][3]}; *(f32x4*)(op + 4) = (f32x4){cur[hf][4], cur[hf][5], cur[hf][6], cur[hf][7]}; } }
    }
}

__device__ __forceinline__ void ffn_fixup(const Args& a, int l, int pm, const int tid) {
    unsigned char* ws = a.ws_();
    const float* hb = (const float*)(ws + WS_HB); bf16_t* Gb = (bf16_t*)(ws + WS_G);
    const float* cw = a.in_(I_FCW) + (size_t)l * 3 * 6144; const float* cb = a.in_(I_FCB) + (size_t)l * 6144;
    for (int cgp = tid; cgp < 768; cgp += 512) {
        const int cc = cgp * 4;
        f32x4 w0[2], w1[2], w2[2], bb[2];
#pragma unroll
        for (int hf = 0; hf < 2; ++hf) { const int col = hf * 3072 + cc; w0[hf] = *(const f32x4*)(cw + col); w1[hf] = *(const f32x4*)(cw + 6144 + col); w2[hf] = *(const f32x4*)(cw + 2 * 6144 + col); bb[hf] = *(const f32x4*)(cb + col); }
        f32x4 l0[4][2], l1[4][2], f0[4][2], f1[4][2];
#pragma unroll
        for (int kq = 0; kq < 4; ++kq) {
            const int grp = pm * 4 + kq; const bool seq0 = (grp & 63) == 0;
#pragma unroll
            for (int hf = 0; hf < 2; ++hf) { const int col = hf * 3072 + cc; const f32x4 z = (f32x4){0.f, 0.f, 0.f, 0.f};
                const float* hp = hb + ((size_t)(grp - 1) * 4) * 6144 + col; const float* hc = hb + ((size_t)grp * 4) * 6144 + col;
                l0[kq][hf] = seq0 ? z : *(const f32x4*)(hp + 2 * 6144); l1[kq][hf] = seq0 ? z : *(const f32x4*)(hp + 3 * 6144); f0[kq][hf] = *(const f32x4*)(hc); f1[kq][hf] = *(const f32x4*)(hc + 6144); }
        }
#pragma unroll
        for (int kq = 0; kq < 4; ++kq) {
            const int grp = pm * 4 + kq;
            f32x4 va[2], vb[2];
#pragma unroll
            for (int hf = 0; hf < 2; ++hf) { va[hf] = bb[hf] + l0[kq][hf] * w0[hf] + l1[kq][hf] * w1[hf] + f0[kq][hf] * w2[hf]; vb[hf] = bb[hf] + l1[kq][hf] * w0[hf] + f0[kq][hf] * w1[hf] + f1[kq][hf] * w2[hf]; }
            u32x2 w; w.x = pk2(gelu_tanh(va[0][0]) * va[1][0], gelu_tanh(va[0][1]) * va[1][1]); w.y = pk2(gelu_tanh(va[0][2]) * va[1][2], gelu_tanh(va[0][3]) * va[1][3]);
            *(u32x2*)(Gb + (size_t)(grp * 64) * DFF + cc) = w;
            w.x = pk2(gelu_tanh(vb[0][0]) * vb[1][0], gelu_tanh(vb[0][1]) * vb[1][1]); w.y = pk2(gelu_tanh(vb[0][2]) * vb[1][2], gelu_tanh(vb[0][3]) * vb[1][3]);
            *(u32x2*)(Gb + (size_t)(grp * 64 + 1) * DFF + cc) = w;
        }
    }
    asm volatile("s_waitcnt vmcnt(0)" ::: "memory");
    __syncthreads();
}

#define XB_TMO      128
#define XB_XCNT(j)  (256  + 64 * (j))
#define XB_XSUB(j)  (1280 + 64 * (j))
#define XB_XGEN(j)  (2304 + 64 * (j))
#define XB_TOP      3328
#define XB_TOPGEN   3392
#define XCD_BAR_WORDS 3456
#define XB_SPIN_CAP (1u << 18)

__device__ __forceinline__ unsigned xb_ld(unsigned* p)              { return __hip_atomic_load(p, __ATOMIC_RELAXED, __HIP_MEMORY_SCOPE_AGENT); }
__device__ __forceinline__ unsigned xb_add(unsigned* p, unsigned v) { return __hip_atomic_fetch_add(p, v, __ATOMIC_RELAXED, __HIP_MEMORY_SCOPE_AGENT); }
__device__ __forceinline__ unsigned xb_xcc_id() { return (unsigned)__builtin_amdgcn_s_getreg((3 << 11) | 20) & 0xFu; }
#define XB_SPIN(cond, bar) do { unsigned _sp = 0; while (cond) { __builtin_amdgcn_s_sleep(1); \
    if ((++_sp & 255u) == 0u) { if (xb_ld(&(bar)[XB_TMO])) break; if (_sp > XB_SPIN_CAP) { atomicAdd(&(bar)[XB_TMO], 1u); break; } } } } while (0)

struct XcdBarrier {
    unsigned* bar; unsigned x;
    volatile LAS unsigned* st; bool t0;
};

__device__ __forceinline__ XcdBarrier xcd_barrier_post(unsigned* bar, volatile LAS unsigned* st, bool t0) {
    XcdBarrier b; b.bar = bar; b.x = xb_xcc_id(); b.st = st; b.t0 = t0;
    if (t0) (void)xb_add(&bar[XB_XCNT(b.x)], 1u);
    return b;
}
__device__ __forceinline__ void xcd_barrier_complete(unsigned* bar, unsigned x, unsigned& nloc, unsigned& nx) {
    const unsigned G = gridDim.x * gridDim.y * gridDim.z;
    unsigned sum, cnt, mine, sp = 0u;
    for (;;) {
        sum = 0u; cnt = 0u; mine = 0u;
#pragma unroll
        for (unsigned j = 0; j < 16; ++j) { const unsigned c = xb_ld(&bar[XB_XCNT(j)]); sum += c; cnt += (c > 0u) ? 1u : 0u; mine = (j == x) ? c : mine; }
        if (sum == G) break;
        __builtin_amdgcn_s_sleep(1);
        if ((++sp & 255u) == 0u) { if (xb_ld(&bar[XB_TMO])) break; if (sp > XB_SPIN_CAP) { atomicAdd(&bar[XB_TMO], 1u); break; } }
    }
    nloc = mine > 0u ? mine : 1u; nx = cnt > 0u ? cnt : 1u;
}

__device__ __forceinline__ void xcd_barrier(const XcdBarrier& b) {
    asm volatile("s_waitcnt vmcnt(0)" ::: "memory");
    __syncthreads();
    if (b.t0) {
        unsigned* bar = b.bar;
        __builtin_amdgcn_s_waitcnt(0);
        unsigned nloc = b.st[0], nx = b.st[1];
        if (nloc == 0u) { xcd_barrier_complete(bar, b.x, nloc, nx); b.st[0] = nloc; b.st[1] = nx; }
        const unsigned old = xb_add(&bar[XB_XSUB(b.x)], 1u);
        const unsigned gen = old / nloc;
        if (old + 1u == (gen + 1u) * nloc) {
            __builtin_amdgcn_fence(__ATOMIC_RELEASE, "agent");
            asm volatile("s_waitcnt vmcnt(0)" ::: "memory");
            const unsigned og = xb_add(&bar[XB_TOP], 1u);
            const unsigned tg = og / nx;
            if (og + 1u == (tg + 1u) * nx) xb_add(&bar[XB_TOPGEN], 1u);
            else XB_SPIN(xb_ld(&bar[XB_TOPGEN]) == tg, bar);
            __builtin_amdgcn_fence(__ATOMIC_ACQUIRE, "agent");
            xb_add(&bar[XB_XGEN(b.x)], 1u);
            asm volatile("s_waitcnt vmcnt(0)" ::: "memory");
        } else {
            XB_SPIN(xb_ld(&bar[XB_XGEN(b.x)]) == gen, bar);
            __builtin_amdgcn_fence(__ATOMIC_ACQUIRE, "agent");
            asm volatile("s_waitcnt vmcnt(0)" ::: "memory");
        }
    }
    __syncthreads();
}


__device__ __forceinline__ void grid_bar(unsigned* ctr, unsigned& epoch, int G, int tid) {
    asm volatile("s_waitcnt vmcnt(0) lgkmcnt(0)" ::: "memory");
    __syncthreads();
    epoch += 1u;
    if (tid == 0) {
        __builtin_amdgcn_fence(__ATOMIC_RELEASE, "agent");
        asm volatile("s_waitcnt vmcnt(0)" ::: "memory");
        __hip_atomic_fetch_add(ctr, 1u, __ATOMIC_RELAXED, __HIP_MEMORY_SCOPE_AGENT);
        const unsigned want = epoch * (unsigned)G; unsigned spins = 0;
        while (__hip_atomic_load(ctr, __ATOMIC_RELAXED, __HIP_MEMORY_SCOPE_AGENT) < want) { __builtin_amdgcn_s_sleep(1); if (++spins > (1u << 24)) break; }
        __builtin_amdgcn_fence(__ATOMIC_ACQUIRE, "agent");
        asm volatile("s_waitcnt vmcnt(0)" ::: "memory");
    }
    __syncthreads();
}

constexpr int NPHASES = 23;
enum { K_PRO = 0, K_INPROJ, K_RA, K_RB, K_ATT, K_OUT, K_UP, K_EW, K_DOWN };

__global__ void __launch_bounds__(NTHREADS, 2) fwd_kernel(KArgs ka) {
    extern __shared__ __attribute__((aligned(16))) unsigned char lds_raw[];
    LAS unsigned char* L = (LAS unsigned char*)lds_raw;
    const int tid_e = threadIdx.x; const int wv_s = __builtin_amdgcn_readfirstlane(tid_e >> 6);
#define TID_NOW() (wv_s * 64 + (int)__builtin_amdgcn_mbcnt_hi(~0u, __builtin_amdgcn_mbcnt_lo(~0u, 0u)))
    {
        LAS unsigned long long* tab = (LAS unsigned long long*)(L + ARGTAB_OFF);
        if (tid_e == 0) {
#pragma unroll
            for (int i = 0; i < 35; ++i) tab[i] = (unsigned long long)ka.in[i];
            tab[35] = (unsigned long long)ka.out; tab[36] = (unsigned long long)ka.ws;
            ((LAS unsigned*)(L + ARGTAB_OFF + 320))[0] = 0u; ((LAS unsigned*)(L + ARGTAB_OFF + 320))[1] = 0u;
        }
        __syncthreads();
    }
    (void)xcd_barrier_post((unsigned*)(ka.ws + WS_CTL), (volatile LAS unsigned*)(L + ARGTAB_OFF + 320), tid_e == 0);
    Args a; a.t = (LAS const unsigned*)(L + ARGTAB_OFF);
    const int ph_lo = ka.ph_lo, ph_hi = ka.ph_hi;
    if (ph_lo == 0) {
        const int tid0 = tid_e, lane0 = tid0 & 63, wave0 = __builtin_amdgcn_readfirstlane(tid0 >> 6), G0 = gridDim.x;
        prologue(a, L, wave0 * G0 + (int)blockIdx.x, G0 * NWAVES, wave0, lane0);
    }
    for (int ph = (ph_lo > 1 ? ph_lo : 1); ph < ph_hi; ++ph) {
        if (ph > ph_lo) {
            if (ph_hi > 1000) cg::this_grid().sync();
            { XcdBarrier xb_; xb_.bar = (unsigned*)(a.ws_() + WS_CTL); xb_.x = xb_xcc_id(); xb_.st = (volatile LAS unsigned*)(L + ARGTAB_OFF + 320); xb_.t0 = (TID_NOW() == 0); xcd_barrier(xb_); }
        }
        int tid = TID_NOW(); asm volatile("" : "+v"(tid));
        int bid = blockIdx.x; asm volatile("" : "+s"(bid));
        int G = gridDim.x; asm volatile("" : "+s"(G));
        unsigned char* ws = a.ws_();
        const int lane = tid & 63, wave = __builtin_amdgcn_readfirstlane(tid >> 6);
        const int gw = wave * G + bid, NGW = G * NWAVES;
        int kind, l;
        if (ph == 0) { kind = K_PRO; l = 0; }
        else if (ph < 13) { l = (ph - 1) / 6; const int k = (ph - 1) % 6; kind = (k == 0) ? K_INPROJ : (k == 1) ? K_RA : (k == 2) ? K_RB : (k == 3) ? K_OUT : (k == 4) ? K_UP : K_DOWN; }
        else { l = 2 + (ph - 13) / 5; const int k = (ph - 13) % 5; kind = (k == 0) ? K_INPROJ : (k == 1) ? K_ATT : (k == 2) ? K_OUT : (k == 3) ? K_UP : K_DOWN; }
        asm volatile("" : "+s"(kind));
        if (kind == K_UP) {
            asm volatile("" : "+s"(l));
            {
                pg8::Gemm g; pg8::StaticOrder S; pg8::EpiFfn E;
                g.A = (const bf16_t*)(ws + WS_XB); g.Bt = (const bf16_t*)(ws + WS_WUP) + (size_t)l * 6144 * DM; g.M = MP; g.N = 6144; g.K = DM;
                S.init(MP, 6144, G, bid);
                E.G = (bf16_t*)(ws + WS_G); E.ssq = (const float*)(ws + WS_SSQ); E.cw = a.in_(I_FCW) + (size_t)l * 3 * 6144; E.cb = a.in_(I_FCB) + (size_t)l * 6144;
                E.hb = (float*)(ws + WS_HB); E.pfc = a.out_() + O_PFC + (size_t)l * 4 * 2 * 6144;
                pg8::gemm_phase<pg8::EpiFfn, pg8::StaticOrder, true, true>(L, g, S, E, tid);
            }
            asm volatile("" : "+s"(l)); asm volatile("" : "+s"(ws));
            {
                const bf16_t* Bt = (const bf16_t*)(ws + WS_WUP) + (size_t)l * 6144 * DM;
                const bf16_t* As = (const bf16_t*)(ws + WS_XB) + (size_t)MP * DM;
                SEpiFfn F{a.in_(I_SFC) + (size_t)l * 128 * 2 * 6144, a.in_(I_FCW) + (size_t)l * 3 * 6144, a.in_(I_FCB) + (size_t)l * 6144, a.out_() + O_SFC + (size_t)l * 128 * 2 * 6144,
                          (bf16_t*)(ws + WS_G), (const float*)(ws + WS_SSQS)};
                small_gemm128(L, As, Bt, 192, bid, G, wave, lane, F);
            }
        } else if (kind == K_INPROJ) {
            asm volatile("" : "+s"(l));
            const int nsub = (kind == K_INPROJ && l == 0) ? 5 : 1;
            const bf16_t* Bt; int N; bf16_t* O; int ldc;
            if (kind == K_UP) { Bt = (const bf16_t*)(ws + WS_WUP) + (size_t)l * 6144 * DM; N = 6144; O = (bf16_t*)(ws + WS_U); ldc = 6144; }
            else if (l < 2) { Bt = (const bf16_t*)(ws + WS_WINA) + (size_t)l * 1792 * DM; N = 1792; O = (bf16_t*)(ws + WS_UIN); ldc = 1792; }
            else if (l == 2) { Bt = (const bf16_t*)(ws + WS_WINB0); N = 1536; O = (bf16_t*)(ws + WS_UIN); ldc = 1536; }
            else { Bt = (const bf16_t*)(ws + WS_WINB1); N = 1024; O = (bf16_t*)(ws + WS_UIN); ldc = 1536; }
            for (int sub = 0; sub < nsub; ++sub) {
                pg8::Gemm g; pg8::StaticOrder S; pg8::EpiScaleBf16 E;
                if (sub < nsub - 1) {
                    g.A = (const bf16_t*)(ws + WS_MEMXB); g.Bt = (const bf16_t*)(ws + WS_WMKV) + (size_t)sub * 512 * DM; g.M = 1024; g.N = 512; g.K = DM;
                    S.init(1024, 512, G, (bid - (192 + 8 * sub) % G + G) % G);
                    E.O = (bf16_t*)(ws + WS_MEMRAW) + (size_t)sub * 1024 * 512; E.ldc = 512; E.ssq = (const float*)(ws + WS_MEMSSQ);
                } else {
                    g.A = (const bf16_t*)(ws + WS_XB); g.Bt = Bt; g.M = MP; g.N = N; g.K = DM;
                    S.init(MP, N, G, bid);
                    E.O = O; E.ldc = ldc; E.ssq = (const float*)(ws + WS_SSQ);
                }
                pg8::gemm_phase<pg8::EpiScaleBf16, pg8::StaticOrder, true, true>(L, g, S, E, tid);
            }
            asm volatile("" : "+s"(l)); asm volatile("" : "+s"(ws));
            if (kind == K_UP) { Bt = (const bf16_t*)(ws + WS_WUP) + (size_t)l * 6144 * DM; N = 6144; }
            else if (l < 2) { Bt = (const bf16_t*)(ws + WS_WINA) + (size_t)l * 1792 * DM; N = 1792; }
            else if (l == 2) { Bt = (const bf16_t*)(ws + WS_WINB0); N = 1536; }
            else { Bt = (const bf16_t*)(ws + WS_WINB1); N = 1024; }
            const bf16_t* As = (const bf16_t*)(ws + WS_XB) + (size_t)MP * DM;
            if (kind == K_UP) {
                SEpiFfn F{a.in_(I_SFC) + (size_t)l * 128 * 2 * 6144, a.in_(I_FCW) + (size_t)l * 3 * 6144, a.in_(I_FCB) + (size_t)l * 6144, a.out_() + O_SFC + (size_t)l * 128 * 2 * 6144,
                          (bf16_t*)(ws + WS_G), (const float*)(ws + WS_SSQS)};
                small_gemm(L, As, Bt, DM, 192, 16, 128, 1, bid, G, wave, lane, F);
            } else {
                SEpiScale F{(float*)(ws + WS_UINS), (const float*)(ws + WS_SSQS)};
                const int nwg = (MP / 256) * (N / 256); const int busy = (l != 0 && nwg > G && nwg < 2 * G) ? nwg - G : 0;
                if (bid >= busy) small_gemm(L, As, Bt, DM, N / 32, 32, 16, 0, bid - busy, G - busy, wave, lane, F);
            }
        } else if (kind == K_OUT || kind == K_DOWN) {
            asm volatile("" : "+s"(l));
            pg8::Gemm g; pg8::StaticOrder S; pg8::EpiResid E;
            const bool first = (kind == K_OUT && l == 0);
            const int K = (kind == K_OUT) ? DM : DFF;
            const bf16_t* A; A = (kind == K_OUT) ? (const bf16_t*)(ws + WS_MIX) : (const bf16_t*)(ws + WS_G);
            const bf16_t* Bt; Bt = (kind == K_OUT) ? (const bf16_t*)(ws + WS_WOUT) + (size_t)l * DM * DM : (const bf16_t*)(ws + WS_WDN) + (size_t)l * DM * DFF;
            g.A = A; g.Bt = Bt; g.M = MP; g.N = DM; g.K = K;
            S.init(MP, DM, G, bid);
            if (kind == K_DOWN) { pg8::Unit u0; if (S.next(0, u0)) ffn_fixup(a, l, u0.pm, tid); }
            E.xb = (bf16_t*)(ws + WS_XB); E.ssq = (float*)(ws + WS_SSQ); E.yout = (kind == K_DOWN && l == 3) ? a.out_() + O_YP : nullptr;
            pg8::gemm_phase<pg8::EpiResid, pg8::StaticOrder, true, true>(L, g, S, E, tid);
            asm volatile("" : "+s"(l)); asm volatile("" : "+s"(ws));
            A = (kind == K_OUT) ? (const bf16_t*)(ws + WS_MIX) : (const bf16_t*)(ws + WS_G);
            Bt = (kind == K_OUT) ? (const bf16_t*)(ws + WS_WOUT) + (size_t)l * DM * DM : (const bf16_t*)(ws + WS_WDN) + (size_t)l * DM * DFF;
            SEpiResid F{first ? a.in_(I_XS) : (const float*)(a.out_() + O_YS), a.out_() + O_YS, (bf16_t*)(ws + WS_XB) + (size_t)MP * DM, (float*)(ws + WS_SSQS)};
            small_gemm(L, A + (size_t)MP * K, Bt, K, 32, 32, 16, 0, bid, G, wave, lane, F);
        } else if (kind == K_RA) {
            asm volatile("" : "+s"(l));
            if (l == 0) memkv_finalize(a, gw, NGW, lane);
            for (int it = bid; it < 1536 + 12 + 128; it += G) { asm volatile("" : "+v"(tid));
                if (it < 1536) rglru_item(a, L, l, 0, it, false, tid);
                else if (it < 1548) rglru_item(a, L, l, 1, it - 1536, true, tid);
                else { const int b = it - 1548;
                    sample_attn_item(a, L, b, 4, 1, 256, a.in_(I_CMK) + ((size_t)l * 128 + b) * 65536, a.in_(I_CMV) + ((size_t)l * 128 + b) * 65536, 1536, a.in_(I_MQNG) + l * 64, false, 0, false, 768, tid); } }
        } else if (kind == K_RB) {
            asm volatile("" : "+s"(l));
            for (int it = bid; it < 768 + 256; it += G) {
                asm volatile("" : "+v"(tid));
                if (it < 768) rglru_scan_item2(a, L, l, 2 * it, tid);
                else memattn_prompt_item(a, L, l, it - 768, tid);
            }
        } else if (kind == K_ATT) {
            asm volatile("" : "+s"(l));
            const int j = l - 2;
            for (int itx = bid; itx < 512 + 256 + 128 + 128; itx += G) {
                asm volatile("" : "+v"(tid));
                const int it = (itx < 256) ? itx + 768 : itx - 256;
                if (it < 512) swa_prompt_item(a, L, j, it, l == 2, tid);
                else if (it < 768) memattn_prompt_item(a, L, l, it - 512, tid);
                else if (it < 896) { const int b = it - 768;
                    sample_attn_item(a, L, b, 12, 3, 128, a.in_(I_CSK) + (size_t)b * 32768, a.in_(I_CSV) + (size_t)b * 32768, 0, a.in_(I_QNG) + j * 64, true, j, l == 2, 0, tid); }
                else { const int b = it - 896;
                    sample_attn_item(a, L, b, 4, 1, 256, a.in_(I_CMK) + ((size_t)l * 128 + b) * 65536, a.in_(I_CMV) + ((size_t)l * 128 + b) * 65536, 768, a.in_(I_MQNG) + l * 64, false, 0, false, 768, tid); }
            }
        }
    }
}

extern "C" void kernel_launch(void* const* d_in, const int* in_sizes, int n_in, void* d_out, int out_size, void* d_ws, size_t ws_size, hipStream_t stream) {
    static int grid = 0;
    if (grid == 0) {
        if (n_in != 35 || out_size != (int)O_END || ws_size < WS_END) { fprintf(stderr, "kernel_launch: unexpected shapes: n_in %d out %d ws %zu (need %zu)\n", n_in, out_size, ws_size, (size_t)WS_END); grid = -1; return; }
        int dev = 0, cus = 0, per_cu = 0;
        hipGetDevice(&dev); hipDeviceGetAttribute(&cus, hipDeviceAttributeMultiprocessorCount, dev);
        if (hipFuncSetAttribute((const void*)fwd_kernel, hipFuncAttributeMaxDynamicSharedMemorySize, LDS_BYTES) != hipSuccess) { fprintf(stderr, "kernel_launch: hipFuncSetAttribute failed\n"); grid = -1; return; }
        if (hipOccupancyMaxActiveBlocksPerMultiprocessor(&per_cu, (const void*)fwd_kernel, NTHREADS, LDS_BYTES) != hipSuccess || per_cu < 1) { fprintf(stderr, "kernel_launch: occupancy query says %d blocks per CU\n", per_cu); per_cu = 1; }
        (void)hipGetLastError();
        grid = cus;
    }
    if (grid < 0) return;
    if (hipMemsetAsync((char*)d_ws + WS_CTL, 0, 16384, stream) != hipSuccess) { fprintf(stderr, "kernel_launch: memset of the barrier word failed\n"); return; }
    KArgs a{};
    for (int i = 0; i < 35; ++i) a.in[i] = (const float*)d_in[i];
    a.out = (float*)d_out; a.ws = (unsigned char*)d_ws;
#if MK_SPLIT
    for (int ph = 0; ph < NPHASES; ++ph) { a.ph_lo = ph; a.ph_hi = ph + 1; hipLaunchKernelGGL(fwd_kernel, dim3(grid), dim3(NTHREADS), LDS_BYTES, stream, a); }
#else
    a.ph_lo = 0; a.ph_hi = NPHASES;
    void* args[] = { &a };
    hipError_t e = hipLaunchCooperativeKernel((const void*)fwd_kernel, dim3(grid), dim3(NTHREADS), args, LDS_BYTES, stream);
    if (e != hipSuccess) fprintf(stderr, "kernel_launch: cooperative launch failed: %s (grid %d)\n", hipGetErrorString(e), grid);
#endif
}
```
